# Optimizing an MI355X kernel written in HIP

```python
import jax, jax.numpy as jnp
from jax import lax
import numpy as np

D_MODEL = 1024
BATCH = 32
SEQ = 2048
DEPTH = 4

CHUNK = 64
N_MIXERS = 2
N_SB = (DEPTH + 1) // 2
N_SGU = DEPTH // 2
SB_HEADS = 16
SB_HEAD_DIM = D_MODEL // SB_HEADS
Q_BLOCK = 128
SGU_CHUNK = 2 * CHUNK
SGU_FFN = 2 * D_MODEL
SGU_GROUPS = 8
SGU_GROUP_W = SGU_FFN // SGU_GROUPS
MLP_HIDDEN = 4 * D_MODEL
EPS = 1e-6

kernel_name = "hybrid_stickbreak_sgu_encoder"


def rmsnorm(x, gain):
    x32 = x.astype(jnp.float32)
    y = x32 * lax.rsqrt(jnp.mean(x32 * x32, axis=-1, keepdims=True) + EPS)
    return (y * gain.astype(jnp.float32)).astype(x.dtype)


def stick_breaking_attention(q, k, v):
    seq = q.shape[2]
    scale = SB_HEAD_DIM ** -0.5
    outs = []
    for blk in range(seq // Q_BLOCK):
        t0 = blk * Q_BLOCK
        t1 = t0 + Q_BLOCK
        qb = q[:, :, t0:t1].astype(jnp.float32)
        kb = k[:, :, :t1].astype(jnp.float32)
        vb = v[:, :, :t1].astype(jnp.float32)
        z = jnp.einsum('bhtd,bhsd->bhts', qb, kb) * scale
        t_idx = t0 + jnp.arange(Q_BLOCK)[:, None]
        s_idx = jnp.arange(t1)[None, :]
        past = s_idx < t_idx
        log_beta = jax.nn.log_sigmoid(z)
        log_one_minus = jnp.where(past, log_beta - z, 0.0)
        suffix = lax.cumsum(log_one_minus, axis=3, reverse=True) - log_one_minus
        a = jnp.where(past, jnp.exp(log_beta + suffix), 0.0)
        outs.append(jnp.einsum('bhts,bhsd->bhtd', a, vb))
    return jnp.concatenate(outs, axis=2).astype(q.dtype)


def stick_breaking_mixer(h, w_qkv, w_o):
    b, s, _ = h.shape
    qkv = (h @ w_qkv).reshape(b, s, 3, SB_HEADS, SB_HEAD_DIM)
    q = jnp.transpose(qkv[:, :, 0], (0, 2, 1, 3))
    k = jnp.transpose(qkv[:, :, 1], (0, 2, 1, 3))
    v = jnp.transpose(qkv[:, :, 2], (0, 2, 1, 3))
    o = stick_breaking_attention(q, k, v)
    o = jnp.transpose(o, (0, 2, 1, 3)).reshape(b, s, D_MODEL)
    return o @ w_o


def spatial_gating_mixer(h, w_in, gain, w_s, b_s, w_out):
    b, s, _ = h.shape
    uv = jax.nn.gelu(h @ w_in)
    u, v = uv[..., :SGU_FFN], uv[..., SGU_FFN:]
    v = rmsnorm(v, gain)
    vc = v.reshape(b, s // SGU_CHUNK, SGU_CHUNK, SGU_GROUPS, SGU_GROUP_W)
    causal = jnp.tril(jnp.ones((SGU_CHUNK, SGU_CHUNK), dtype=bool))
    ws = jnp.where(causal[None], w_s, 0.0).astype(v.dtype)
    mixed = jnp.einsum('gts,bnsgc->bntgc', ws, vc) + jnp.transpose(b_s)[None, None, :, :, None]
    y = u * mixed.reshape(b, s, SGU_FFN)
    return y @ w_out


def squared_relu_mlp(h, w1, w2):
    return jnp.square(jax.nn.relu(h @ w1)) @ w2


def setup_inputs(seed: int = 0) -> dict:
    key = jax.random.key(seed)
    ks = jax.random.split(key, 14)
    f32 = jnp.float32
    nrm = lambda k, shape, scale: jax.random.normal(k, shape, f32) * scale
    return {
        "x": jax.random.normal(ks[0], (BATCH, SEQ, D_MODEL), f32),
        "norm_mix": 1.0 + nrm(ks[1], (DEPTH, D_MODEL), 0.02),
        "norm_mlp": 1.0 + nrm(ks[2], (DEPTH, D_MODEL), 0.02),
        "sb_wqkv": nrm(ks[3], (N_SB, D_MODEL, 3 * D_MODEL), D_MODEL ** -0.5),
        "sb_wo": nrm(ks[4], (N_SB, D_MODEL, D_MODEL), D_MODEL ** -0.5),
        "sgu_win": nrm(ks[5], (N_SGU, D_MODEL, 2 * SGU_FFN), D_MODEL ** -0.5),
        "sgu_gain": 1.0 + nrm(ks[6], (N_SGU, SGU_FFN), 0.02),
        "sgu_ws": nrm(ks[7], (N_SGU, SGU_GROUPS, SGU_CHUNK, SGU_CHUNK), SGU_CHUNK ** -0.5),
        "sgu_bs": 1.0 + nrm(ks[8], (N_SGU, SGU_GROUPS, SGU_CHUNK), 0.02),
        "sgu_wout": nrm(ks[9], (N_SGU, SGU_FFN, D_MODEL), SGU_FFN ** -0.5),
        "mlp_w1": nrm(ks[10], (DEPTH, D_MODEL, MLP_HIDDEN), D_MODEL ** -0.5),
        "mlp_w2": nrm(ks[11], (DEPTH, MLP_HIDDEN, D_MODEL), 0.5 * MLP_HIDDEN ** -0.5),
        "final_norm": 1.0 + nrm(ks[12], (D_MODEL,), 0.02),
    }


def reference(x, norm_mix, norm_mlp, sb_wqkv, sb_wo, sgu_win, sgu_gain, sgu_ws,
              sgu_bs, sgu_wout, mlp_w1, mlp_w2, final_norm):
    for i in range(DEPTH):
        h = rmsnorm(x, norm_mix[i])
        j = i // N_MIXERS
        if i % N_MIXERS == 0:
            x = x + stick_breaking_mixer(h, sb_wqkv[j], sb_wo[j])
        else:
            x = x + spatial_gating_mixer(h, sgu_win[j], sgu_gain[j], sgu_ws[j],
                                         sgu_bs[j], sgu_wout[j])
        x = x + squared_relu_mlp(rmsnorm(x, norm_mlp[i]), mlp_w1[i], mlp_w2[i])
    return rmsnorm(x, final_norm)
```

```cpp
#include <hip/hip_runtime.h>
#include <hip/hip_cooperative_groups.h>
#include <cstdio>
#include <cstdint>
namespace cg = cooperative_groups;
namespace pg8 {
#define PG8_LAS __attribute__((address_space(3)))
typedef unsigned short bf16_t;
typedef short bf16x8 __attribute__((ext_vector_type(8)));
typedef float f32x4 __attribute__((ext_vector_type(4)));
typedef unsigned u32x4 __attribute__((ext_vector_type(4)));
constexpr int BM = 256, BK = 64, HALF = 128, HTB = HALF * BK * 2  , STAGE_BYTES = 8 * HTB, NXCD = 8, WGM = 8;

__host__ __device__ __forceinline__ int lds_byte(int r, int c) { const int st = (r >> 4) * 2 + (c >> 5), rr = r & 15, cc = c & 31, ob = rr * 64 + cc * 2; return st * 1024 + (ob ^ (((ob >> 9) & 1) << 5)); }
__host__ __device__ __forceinline__ void stage_rc(int b, int& R, int& C) { const int st = b / 1024, sb = b % 1024, swz = sb ^ (((sb >> 9) & 1) << 5); R = (st >> 1) * 16 + swz / 64; C = (st & 1) * 32 + (swz % 64) / 2; }
__host__ __device__ __forceinline__ int perm32(int rho) { const int n = rho >> 4, i = rho & 15; return 8 * (i >> 2) + 4 * n + (i & 3); }

struct Unit { int pm, pn; };
struct Gemm { const bf16_t* A; const bf16_t* Bt; int M, N, K; };

struct StaticOrder {
    int nM, nN, nwg, G, c;
    __host__ __device__ void init(int M, int N, int G_, int c_) { nM = M / BM; nN = N / BM; nwg = nM * nN; G = G_; c = c_; }
    __host__ __device__ bool next(int i, Unit& u) const {
        const long L = (long)i * G + c; if (L >= nwg) return false;
        int wgid = (int)L; { const int q = nwg / NXCD, r = nwg % NXCD, xcd = wgid % NXCD, off = wgid / NXCD; wgid = (xcd < r ? xcd * (q + 1) : r * (q + 1) + (xcd - r) * q) + off; }
        const int nig = WGM * nN, gid = wgid / nig, fm = gid * WGM, gsz = (nM - fm) < WGM ? (nM - fm) : WGM;
        u.pm = fm + ((wgid % nig) % gsz); u.pn = (wgid % nig) / gsz; return true;
    }
    __device__ __forceinline__ void a_ready(const Unit&) const {}
    __device__ __forceinline__ void done(const Unit&) const {}
};

typedef float f32x2_t __attribute__((ext_vector_type(2))); typedef __bf16 bf16x2_t __attribute__((ext_vector_type(2)));
__device__ __forceinline__ unsigned pk2(float lo, float hi) { f32x2_t v = {lo, hi}; bf16x2_t b = __builtin_convertvector(v, bf16x2_t); return __builtin_bit_cast(unsigned, b); }
constexpr float NORM_EPS = 1e-6f;
template <int ACT> __device__ __forceinline__ float act_fn(float x) {
    if (ACT == 1) { const float v = fmaxf(x, 0.f); return v * v; }
    if (ACT == 2) { const float e = __builtin_amdgcn_exp2f(-2.302208198f * x * (1.f + 0.044715f * x * x)); return x * __builtin_amdgcn_rcpf(1.f + e); }
    return x;
}
template <int ACT> struct EpiRow {
    static constexpr bool PERM = true, AFTER_DRAIN = false;
    bf16_t* O; int ldc; const float* stat; float inv_n; int split_cols; size_t split_stride; float scale0;
    __device__ __forceinline__ void operator()(const f32x4 (&acc)[2][2][4][2], const Unit& u, int wr, int wc, int fr, int fq) const {
        const int row0 = u.pm * BM + wr * 64 + fr; int colt = u.pn * BM; bf16_t* base = O; float sc = 1.f;
        if (split_cols) { const int t = colt / split_cols; base += (size_t)t * split_stride; colt -= t * split_cols; if (t == 0) sc = scale0; }
        const int col0 = colt + wc * 32 + 8 * fq;
#pragma unroll
        for (int ai = 0; ai < 2; ++ai)
#pragma unroll
            for (int m = 0; m < 4; ++m) { const int row = row0 + ai * HALF + m * 16; float rs; { const f32x4 p4 = *(const f32x4*)(stat + (size_t)row * 16 + 4 * fq); float s = (p4[0] + p4[1]) + (p4[2] + p4[3]); s += __shfl_xor(s, 16); s += __shfl_xor(s, 32); rs = __builtin_amdgcn_rsqf(s * inv_n + NORM_EPS); }
                bf16_t* rowp = base + (size_t)row * ldc + col0;
#pragma unroll
                for (int bj = 0; bj < 2; ++bj) { f32x4 v0 = acc[ai][bj][m][0] * rs, v1 = acc[ai][bj][m][1] * rs;
#pragma unroll
                    for (int e = 0; e < 4; ++e) { v0[e] = act_fn<ACT>(v0[e]) * sc; v1[e] = act_fn<ACT>(v1[e]) * sc; }
                    u32x4 w; w.x = pk2(v0[0], v0[1]); w.y = pk2(v0[2], v0[3]); w.z = pk2(v1[0], v1[1]); w.w = pk2(v1[2], v1[3]);
                    *(u32x4*)(rowp + bj * HALF) = w; } }
    }
};
template <int ACT, bool VSTAT> struct EpiCol {
    static constexpr bool PERM = true, AFTER_DRAIN = false;
    bf16_t* O; size_t ldc; const float* stat; float inv_n; float* vstat;
    __device__ __forceinline__ void operator()(const f32x4 (&acc)[2][2][4][2], const Unit& u, int wr, int wc, int fr, int fq) const {
        const int row0 = u.pm * BM + wr * 64 + fr; const int col0 = u.pn * BM + wc * 32 + 8 * fq;
        f32x4 rsv[2][2], sq[2][2];
        const int lane_ = fq * 16 + fr; float myrs;
        { const f32x4* sp = (const f32x4*)(stat + (size_t)(col0 + (fr >> 3) * HALF + (fr & 7)) * 16); const f32x4 q0 = sp[0], q1 = sp[1], q2 = sp[2], q3 = sp[3];
          const f32x4 q = (q0 + q1) + (q2 + q3); myrs = __builtin_amdgcn_rsqf(((q[0] + q[1]) + (q[2] + q[3])) * inv_n + NORM_EPS); }
#pragma unroll
        for (int bj = 0; bj < 2; ++bj)
#pragma unroll
            for (int n = 0; n < 2; ++n) {
#pragma unroll
                for (int e = 0; e < 4; ++e) rsv[bj][n][e] = __shfl(myrs, (lane_ & 48) | (bj * 8 + n * 4 + e));
                sq[bj][n] = (f32x4){0.f, 0.f, 0.f, 0.f}; }
#pragma unroll
        for (int ai = 0; ai < 2; ++ai)
#pragma unroll
            for (int m = 0; m < 4; ++m) { bf16_t* rowp = O + (size_t)(row0 + ai * HALF + m * 16) * ldc + col0;
#pragma unroll
                for (int bj = 0; bj < 2; ++bj) { f32x4 v0 = acc[ai][bj][m][0] * rsv[bj][0], v1 = acc[ai][bj][m][1] * rsv[bj][1];
#pragma unroll
                    for (int e = 0; e < 4; ++e) { v0[e] = act_fn<ACT>(v0[e]); v1[e] = act_fn<ACT>(v1[e]); }
                    if (VSTAT) { sq[bj][0] += v0 * v0; sq[bj][1] += v1 * v1; }
                    u32x4 w; w.x = pk2(v0[0], v0[1]); w.y = pk2(v0[2], v0[3]); w.z = pk2(v1[0], v1[1]); w.w = pk2(v1[2], v1[3]);
                    *(u32x4*)(rowp + bj * HALF) = w; } }
        if (VSTAT) {
#pragma unroll
            for (int bj = 0; bj < 2; ++bj)
#pragma unroll
                for (int n = 0; n < 2; ++n)
#pragma unroll
                    for (int e = 0; e < 4; ++e) { float s = sq[bj][n][e]; s += __shfl_xor(s, 1); s += __shfl_xor(s, 2); s += __shfl_xor(s, 4); s += __shfl_xor(s, 8);
                        if (fr == bj * 8 + n * 4 + e) vstat[(size_t)(col0 + bj * HALF + 4 * n + e) * 16 + u.pm * 2 + wr] = s; }
        }
    }
};
struct EpiRes {
    static constexpr bool PERM = true, AFTER_DRAIN = false;
    const float* base; float* out; bf16_t* xb; float* stat; int ldc;
    __device__ __forceinline__ void operator()(const f32x4 (&acc)[2][2][4][2], const Unit& u, int wr, int wc, int fr, int fq) const {
        const int row0 = u.pm * BM + wr * 64 + fr; const int col0 = u.pn * BM + wc * 32 + 8 * fq;
#pragma unroll
        for (int ai = 0; ai < 2; ++ai)
#pragma unroll
            for (int m = 0; m < 4; ++m) { const int row = row0 + ai * HALF + m * 16; const size_t off = (size_t)row * ldc + col0; float ss = 0.f;
#pragma unroll
                for (int bj = 0; bj < 2; ++bj) { const f32x4 b0 = *(const f32x4*)(base + off + bj * HALF), b1 = *(const f32x4*)(base + off + bj * HALF + 4);
                    const f32x4 v0 = b0 + acc[ai][bj][m][0], v1 = b1 + acc[ai][bj][m][1];
                    *(f32x4*)(out + off + bj * HALF) = v0; *(f32x4*)(out + off + bj * HALF + 4) = v1;
                    ss += (v0[0] * v0[0] + v0[1] * v0[1]) + (v0[2] * v0[2] + v0[3] * v0[3]) + (v1[0] * v1[0] + v1[1] * v1[1]) + (v1[2] * v1[2] + v1[3] * v1[3]);
                    u32x4 w; w.x = pk2(v0[0], v0[1]); w.y = pk2(v0[2], v0[3]); w.z = pk2(v1[0], v1[1]); w.w = pk2(v1[2], v1[3]);
                    *(u32x4*)(xb + off + bj * HALF) = w; }
                ss += __shfl_xor(ss, 16); ss += __shfl_xor(ss, 32);
                if (fq == 0) stat[(size_t)row * 16 + u.pn * 4 + wc] = ss; }
    }
};

template <class Epi, class Sched, bool ALIGN_EPI = false, bool SP2 = false>
__device__ __forceinline__ void gemm_phase(PG8_LAS unsigned char* lds, const Gemm g, const Sched& S0, const Epi& E) {
    Sched S = S0; asm volatile("" : "+s"(S.c));
    int tid_ = threadIdx.x, K_ = g.K; asm volatile("" : "+v"(tid_), "+s"(K_));
    const int tid = tid_, wid = __builtin_amdgcn_readfirstlane(tid >> 6), lane = tid & 63, wr = wid >> 2, wc = wid & 3, fr = lane & 15, fq = lane >> 4;
    const int K = K_, nt = K / BK;
    unsigned voffA[2], voffB[2];
#pragma unroll
    for (int i = 0; i < 2; ++i) { int R, C; stage_rc(tid * 16 + i * 8192, R, C); const int Rb = Epi::PERM ? ((R & ~31) + perm32(R & 31)) : R;
        voffA[i] = (unsigned)(R * K + C) * 2u; voffB[i] = (unsigned)(Rb * K + C) * 2u; }
    const size_t kstep = (size_t)(BK * 2);
    const size_t hstep = (size_t)HALF * K * 2;
    const size_t tstep = 2 * hstep;
    const unsigned ldsw = (unsigned)wid * 1024u;
    const int aoff = lds_byte(wr * 64 + fr, fq * 8), boff = lds_byte(wc * 32 + fr, fq * 8);
#define PG8_SA(b, h) (((b) * 2 + (h)) * HTB)
#define PG8_SB(b, h) ((4 + (b) * 2 + (h)) * HTB)
#define PG8_STAGE(bufoff, gbase, voff) do { _Pragma("unroll") for (int _i = 0; _i < 2; ++_i) \
        __builtin_amdgcn_global_load_lds((const unsigned*)((const char*)(gbase) + (voff)[_i]), (PG8_LAS unsigned*)(lds + (bufoff) + ldsw + _i * 8192), 16, 0, 0); } while (0)
#define PG8_LDA(dst, b, h) do { _Pragma("unroll") for (int m = 0; m < 4; ++m) _Pragma("unroll") for (int k = 0; k < 2; ++k) dst[m][k] = *(const PG8_LAS bf16x8*)(lds + PG8_SA(b, h) + aoff + m * 2048 + k * 1024); } while (0)
#define PG8_LDB(dst, b, h) do { _Pragma("unroll") for (int n = 0; n < 2; ++n) _Pragma("unroll") for (int k = 0; k < 2; ++k) dst[n][k] = *(const PG8_LAS bf16x8*)(lds + PG8_SB(b, h) + boff + n * 2048 + k * 1024); } while (0)
#define PG8_MMA(ai, bj, At, Bt) do { __builtin_amdgcn_s_setprio(1); _Pragma("unroll") for (int m = 0; m < 4; ++m) _Pragma("unroll") for (int n = 0; n < 2; ++n) _Pragma("unroll") for (int k = 0; k < 2; ++k) \
        acc[ai][bj][m][n] = __builtin_amdgcn_mfma_f32_16x16x32_bf16(Bt[n][k], At[m][k], acc[ai][bj][m][n], 0, 0, 0); __builtin_amdgcn_s_setprio(0); } while (0)
#define PG8_WAIT_V(n) asm volatile("s_waitcnt vmcnt(" #n ")" ::: "memory")
#define PG8_WAIT_L(n) asm volatile("s_waitcnt lgkmcnt(" #n ")" ::: "memory")
#define PG8_BAR __builtin_amdgcn_s_barrier()
#define PG8_SCHED __builtin_amdgcn_sched_barrier(0)
    Unit cur, nxt; int ui = 0;
    if (!S.next(0, cur)) return;
    f32x4 acc[2][2][4][2];
#pragma unroll
    for (int a = 0; a < 2; ++a)
#pragma unroll
        for (int b = 0; b < 2; ++b)
#pragma unroll
            for (int m = 0; m < 4; ++m)
#pragma unroll
                for (int n = 0; n < 2; ++n) acc[a][b][m][n] = (f32x4){0.f, 0.f, 0.f, 0.f};
    bf16x8 At[4][2], B0[2][2], B1[2][2];
    const char* cA = (const char*)g.A + (size_t)cur.pm * tstep; const char* cB = (const char*)g.Bt + (size_t)cur.pn * tstep;
    S.a_ready(cur);
    if constexpr (SP2) {
        PG8_STAGE(PG8_SB(0, 0), cB, voffB); PG8_STAGE(PG8_SB(0, 1), cB + hstep, voffB); PG8_STAGE(PG8_SA(0, 0), cA, voffA); PG8_STAGE(PG8_SA(0, 1), cA + hstep, voffA);
        if (wr == 1) PG8_BAR;
        PG8_WAIT_V(2); PG8_BAR;
        PG8_STAGE(PG8_SB(1, 0), cB + kstep, voffB); PG8_STAGE(PG8_SA(1, 0), cA + kstep, voffA); PG8_STAGE(PG8_SB(1, 1), cB + hstep + kstep, voffB);
        PG8_WAIT_V(6); PG8_BAR;
    } else {
        PG8_STAGE(PG8_SB(0, 0), cB, voffB); PG8_STAGE(PG8_SA(0, 0), cA, voffA); PG8_STAGE(PG8_SB(0, 1), cB + hstep, voffB); PG8_STAGE(PG8_SA(0, 1), cA + hstep, voffA);
        if (wr == 1) PG8_BAR;
        PG8_WAIT_V(4); PG8_BAR;
        PG8_STAGE(PG8_SB(1, 0), cB + kstep, voffB); PG8_STAGE(PG8_SA(1, 0), cA + kstep, voffA); PG8_STAGE(PG8_SB(1, 1), cB + hstep + kstep, voffB);
        PG8_WAIT_V(6); PG8_BAR;
    }
    for (;;) {
        const bool has_next = S.next(ui + 1, nxt);
        const char* nA = has_next ? (const char*)g.A + (size_t)nxt.pm * tstep : cA; const char* nB = has_next ? (const char*)g.Bt + (size_t)nxt.pn * tstep : cB;
        for (int t = 0; t < nt; t += 2) {
            const bool last = (t == nt - 2);
            const char* a1 = cA + (size_t)(t + 1) * kstep;
            const char* a2 = last ? nA : cA + (size_t)(t + 2) * kstep; const char* b2 = last ? nB : cB + (size_t)(t + 2) * kstep;
            const char* a3 = a2 + kstep; const char* b3 = b2 + kstep;
            if (last && has_next) S.a_ready(nxt);
            if constexpr (SP2) {
            PG8_LDB(B0, 0, 0); PG8_LDB(B1, 0, 1); PG8_SCHED; PG8_LDA(At, 0, 0); PG8_STAGE(PG8_SA(1, 1), a1 + hstep, voffA);
            PG8_WAIT_V(8); PG8_WAIT_L(0); PG8_BAR; PG8_MMA(0, 0, At, B0); PG8_MMA(0, 1, At, B1); PG8_BAR; PG8_SCHED;
            PG8_LDA(At, 0, 1); PG8_STAGE(PG8_SB(0, 0), b2, voffB); PG8_STAGE(PG8_SB(0, 1), b2 + hstep, voffB); PG8_STAGE(PG8_SA(0, 0), a2, voffA);
            PG8_WAIT_V(8); PG8_WAIT_L(0); PG8_BAR; PG8_MMA(1, 0, At, B0); PG8_MMA(1, 1, At, B1); PG8_BAR; PG8_SCHED;
            PG8_LDB(B0, 1, 0); PG8_LDB(B1, 1, 1); PG8_SCHED; PG8_LDA(At, 1, 0); PG8_STAGE(PG8_SA(0, 1), a2 + hstep, voffA);
            PG8_WAIT_V(8); PG8_WAIT_L(0); PG8_BAR; PG8_MMA(0, 0, At, B0); PG8_MMA(0, 1, At, B1); PG8_BAR; PG8_SCHED;
            PG8_LDA(At, 1, 1); PG8_STAGE(PG8_SB(1, 0), b3, voffB); PG8_STAGE(PG8_SB(1, 1), b3 + hstep, voffB); PG8_STAGE(PG8_SA(1, 0), a3, voffA);
            PG8_WAIT_V(8); PG8_WAIT_L(0); PG8_BAR; PG8_MMA(1, 0, At, B0); PG8_MMA(1, 1, At, B1); PG8_BAR; PG8_SCHED;
            } else {
            PG8_LDB(B0, 0, 0); PG8_SCHED; PG8_LDA(At, 0, 0); PG8_STAGE(PG8_SA(1, 1), a1 + hstep, voffA);
            PG8_WAIT_L(8); PG8_BAR; PG8_WAIT_L(0); PG8_MMA(0, 0, At, B0); PG8_BAR; PG8_SCHED;
            PG8_LDB(B1, 0, 1); PG8_STAGE(PG8_SB(0, 0), b2, voffB);
            PG8_BAR; PG8_WAIT_L(0); PG8_MMA(0, 1, At, B1); PG8_BAR;
            PG8_LDA(At, 0, 1); PG8_STAGE(PG8_SA(0, 0), a2, voffA);
            PG8_BAR; PG8_WAIT_L(0); PG8_MMA(1, 0, At, B0); PG8_BAR; PG8_SCHED;
            PG8_STAGE(PG8_SB(0, 1), b2 + hstep, voffB);
            PG8_WAIT_V(6); PG8_BAR; PG8_MMA(1, 1, At, B1); PG8_BAR;
            PG8_LDB(B0, 1, 0); PG8_SCHED; PG8_LDA(At, 1, 0); PG8_STAGE(PG8_SA(0, 1), a2 + hstep, voffA);
            PG8_WAIT_L(8); PG8_BAR; PG8_WAIT_L(0); PG8_MMA(0, 0, At, B0); PG8_BAR; PG8_SCHED;
            PG8_LDB(B1, 1, 1); PG8_STAGE(PG8_SB(1, 0), b3, voffB);
            PG8_BAR; PG8_WAIT_L(0); PG8_MMA(0, 1, At, B1); PG8_BAR;
            PG8_LDA(At, 1, 1); PG8_STAGE(PG8_SA(1, 0), a3, voffA);
            PG8_BAR; PG8_WAIT_L(0); PG8_MMA(1, 0, At, B0); PG8_BAR; PG8_SCHED;
            PG8_STAGE(PG8_SB(1, 1), b3 + hstep, voffB);
            PG8_WAIT_V(6); PG8_BAR; PG8_MMA(1, 1, At, B1); PG8_BAR;
            }
        }
        if constexpr (ALIGN_EPI) { if (wr == 0) PG8_BAR; }
        if constexpr (!Epi::AFTER_DRAIN) { E(acc, cur, wr, wc, fr, fq); S.done(cur); }
        if (!has_next) break;
#pragma unroll
        for (int a = 0; a < 2; ++a)
#pragma unroll
            for (int b = 0; b < 2; ++b)
#pragma unroll
                for (int m = 0; m < 4; ++m)
#pragma unroll
                    for (int n = 0; n < 2; ++n) acc[a][b][m][n] = (f32x4){0.f, 0.f, 0.f, 0.f};
        cur = nxt; cA = nA; cB = nB; ++ui;
        if constexpr (ALIGN_EPI) { if (wr == 1) PG8_BAR; }
    }
    PG8_WAIT_V(0);
    if constexpr (!ALIGN_EPI) { if (wr == 0) PG8_BAR; }
    PG8_BAR;
    if constexpr (Epi::AFTER_DRAIN) { E.fused(acc, cur, wr, wc, fr, fq, lds, wid, lane); S.done(cur); }
#undef PG8_SA
#undef PG8_SB
#undef PG8_STAGE
#undef PG8_LDA
#undef PG8_LDB
#undef PG8_MMA
#undef PG8_WAIT_V
#undef PG8_WAIT_L
#undef PG8_BAR
#undef PG8_SCHED
}
}
#define LAS __attribute__((address_space(3)))
typedef unsigned short bf16_t;
typedef short bf16x8 __attribute__((ext_vector_type(8)));
typedef short s16x4 __attribute__((ext_vector_type(4)));
typedef float f32x4 __attribute__((ext_vector_type(4)));
typedef float f32x16 __attribute__((ext_vector_type(16)));
typedef unsigned u32x4 __attribute__((ext_vector_type(4)));
typedef unsigned u32x2 __attribute__((ext_vector_type(2)));
using pg8::pk2;
#define MFMA32(a, b, c) __builtin_amdgcn_mfma_f32_32x32x16_bf16((a), (b), (c), 0, 0, 0)
#define LDS_WAIT() asm volatile("s_waitcnt lgkmcnt(0)" ::: "memory")

constexpr int BATCH = 32, SEQ = 2048, D = 1024, M = BATCH * SEQ, DEPTH = 4, NH = 16, HD = 64, FF = 4096, SF = 2048, SG = 8, SC = 128, SGW = 256;
constexpr float EPS = 1e-6f;
constexpr float QSCALE = 0.125f * 1.4426950408889634f;
constexpr size_t MiB = 1u << 20;
constexpr size_t WS_WQKV = 4 * MiB;
constexpr size_t WS_WO = 16 * MiB;
constexpr size_t WS_WIN = 20 * MiB;
constexpr size_t WS_WOUT = 36 * MiB;
constexpr size_t WS_W1 = 44 * MiB;
constexpr size_t WS_W2 = 76 * MiB;
constexpr size_t WS_XB = 112 * MiB;
constexpr size_t WS_BIG = 240 * MiB;
constexpr size_t WS_STAT = 752 * MiB;
constexpr size_t STAT_ELEMS = (size_t)M * 16;
constexpr size_t WS_END = 796 * MiB;
constexpr int LDS_BYTES = 147456;

__device__ __forceinline__ int crow(int reg, int h) { return (reg & 3) + 8 * (reg >> 2) + 4 * h; }
__device__ __forceinline__ float wave_sum(float v) {
#pragma unroll
    for (int o = 1; o < 64; o <<= 1) v += __shfl_xor(v, o);
    return v;
}
__device__ __forceinline__ float bf2f(bf16_t v) { return __uint_as_float((unsigned)v << 16); }
__device__ __forceinline__ bf16_t f2bf(float v) { return (bf16_t)(pk2(v, 0.f) & 0xffffu); }

__device__ __forceinline__ void tr_item(const float* W, const float* gain, int K, int N, bf16_t* WT, LAS float* scr, int item, int lane) {
    const int nblk = N / 32, kb = item / nblk, nb = item % nblk, k0 = 64 * kb, n0 = 32 * nb;
#pragma unroll 8
    for (int i = 0; i < 32; ++i) { const int kk = 2 * i + (lane >> 5); float w = W[(size_t)(k0 + kk) * N + n0 + (lane & 31)]; if (gain) w *= gain[k0 + kk]; scr[kk * 33 + (lane & 31)] = w; }
    LDS_WAIT(); asm volatile("" ::: "memory");
    const int c = lane & 7;
#pragma unroll
    for (int jj = 0; jj < 4; ++jj) { const int n = (lane >> 3) + 8 * jj; const LAS float* s = scr + (8 * c) * 33 + n;
        u32x4 o; o.x = pk2(s[0 * 33], s[1 * 33]); o.y = pk2(s[2 * 33], s[3 * 33]); o.z = pk2(s[4 * 33], s[5 * 33]); o.w = pk2(s[6 * 33], s[7 * 33]);
        *(u32x4*)(WT + (size_t)(n0 + n) * K + k0 + 8 * c) = o; }
    LDS_WAIT(); asm volatile("" ::: "memory");
}

struct Args { const float* in[13]; float* out; unsigned char* ws; };

#define OPAQUE_IDS() int tid_ = threadIdx.x, bx_ = blockIdx.x; asm volatile("" : "+v"(tid_), "+s"(bx_)); const int tid = tid_, lane = tid & 63, wave = __builtin_amdgcn_readfirstlane(tid >> 6); \
    const int G = gridDim.x, vcu = (G % 8 == 0) ? (bx_ % 8) * (G / 8) + bx_ / 8 : bx_; (void)tid; (void)lane; (void)wave; (void)vcu
__device__ __forceinline__ void p0_prologue(const Args& a, LAS unsigned char* lds) {
    OPAQUE_IDS();
    unsigned char* ws = a.ws;
    LAS float* scr = (LAS float*)(lds + wave * 16384);
    const int gw = vcu * 8 + wave, NGW = G * 8;
    constexpr int I_QKV = 16 * 96, I_O = 16 * 32, I_IN = 16 * 128, I_OUT = 32 * 32, I_1 = 16 * 128, I_2 = 64 * 32;
    constexpr int NITEMS = 2 * I_QKV + 2 * I_O + 2 * I_IN + 2 * I_OUT + 4 * I_1 + 4 * I_2;
    for (int it = gw; it < NITEMS; it += NGW) {
        int r = it; const float* W; const float* gain = nullptr; int K, N; bf16_t* WT;
        if (r < 2 * I_QKV) { const int j = r / I_QKV; r -= j * I_QKV; W = a.in[3] + (size_t)j * D * 3 * D; gain = a.in[1] + (size_t)(2 * j) * D; K = D; N = 3 * D; WT = (bf16_t*)(ws + WS_WQKV) + (size_t)j * 3 * D * D; }
        else if ((r -= 2 * I_QKV) < 2 * I_O) { const int j = r / I_O; r -= j * I_O; W = a.in[4] + (size_t)j * D * D; K = D; N = D; WT = (bf16_t*)(ws + WS_WO) + (size_t)j * D * D; }
        else if ((r -= 2 * I_O) < 2 * I_IN) { const int j = r / I_IN; r -= j * I_IN; W = a.in[5] + (size_t)j * D * 2 * SF; gain = a.in[1] + (size_t)(2 * j + 1) * D; K = D; N = 2 * SF; WT = (bf16_t*)(ws + WS_WIN) + (size_t)j * 2 * SF * D; }
        else if ((r -= 2 * I_IN) < 2 * I_OUT) { const int j = r / I_OUT; r -= j * I_OUT; W = a.in[9] + (size_t)j * SF * D; K = SF; N = D; WT = (bf16_t*)(ws + WS_WOUT) + (size_t)j * D * SF; }
        else if ((r -= 2 * I_OUT) < 4 * I_1) { const int j = r / I_1; r -= j * I_1; W = a.in[10] + (size_t)j * D * FF; gain = a.in[2] + (size_t)j * D; K = D; N = FF; WT = (bf16_t*)(ws + WS_W1) + (size_t)j * FF * D; }
        else { r -= 4 * I_1; const int j = r / I_2; r -= j * I_2; W = a.in[11] + (size_t)j * FF * D; K = FF; N = D; WT = (bf16_t*)(ws + WS_W2) + (size_t)j * D * FF; }
        tr_item(W, gain, K, N, WT, scr, r, lane);
    }
    const float* x = a.in[0]; bf16_t* XB = (bf16_t*)(ws + WS_XB); float* stat = (float*)(ws + WS_STAT);
    for (int m = gw; m < M; m += NGW) {
        const f32x4* xr = (const f32x4*)(x + (size_t)m * D) + lane; f32x4 v[4]; float s = 0.f;
#pragma unroll
        for (int jj = 0; jj < 4; ++jj) { v[jj] = xr[64 * jj]; s += (v[jj].x * v[jj].x + v[jj].y * v[jj].y) + (v[jj].z * v[jj].z + v[jj].w * v[jj].w); }
        s = wave_sum(s); if (lane < 16) stat[(size_t)m * 16 + lane] = (lane == 0) ? s : 0.f;
        u32x2* o8 = (u32x2*)(XB + (size_t)m * D) + lane;
#pragma unroll
        for (int jj = 0; jj < 4; ++jj) { u32x2 w; w.x = pk2(v[jj].x, v[jj].y); w.y = pk2(v[jj].z, v[jj].w); o8[64 * jj] = w; }
    }
}

__device__ __forceinline__ void attn_phase(const bf16_t* __restrict__ Q, const bf16_t* __restrict__ Kb, const bf16_t* __restrict__ VT, bf16_t* __restrict__ O) {
    OPAQUE_IDS();
    const int r = lane & 31, h = lane >> 5;
    for (int u = vcu; u < BATCH * NH * (SEQ / 256); u += G) {
        const int qb = u & 7, bh = u >> 3, hh = bh & 15, b = bh >> 4;
        const int t0 = qb * 256 + wave * 32;
        const size_t rowb = (size_t)b * SEQ;
        bf16x8 qf[4];
        { const bf16_t* qp = Q + (rowb + t0 + r) * D + hh * HD + h * 8;
#pragma unroll
          for (int d0 = 0; d0 < 4; ++d0) qf[d0] = *(const bf16x8*)(qp + d0 * 16); }
        f32x16 o0, o1;
#pragma unroll
        for (int i = 0; i < 16; ++i) { o0[i] = 0.f; o1[i] = 0.f; }
        float carry = 1.f;
        const bf16_t* kbase = Kb + (rowb + r) * D + hh * HD + h * 8;
        const bf16_t* vbase = VT + (size_t)(hh * HD + r) * M + rowb + 4 * h;
        bf16x8 kf[4]; s16x4 va[2][2][2];
#define ATT_LOAD(KF, VA, s0_) do { const bf16_t* kp_ = kbase + (size_t)(s0_) * D; const bf16_t* vp_ = vbase + (s0_); \
        _Pragma("unroll") for (int d0 = 0; d0 < 4; ++d0) KF[d0] = *(const bf16x8*)(kp_ + d0 * 16); \
        _Pragma("unroll") for (int db = 0; db < 2; ++db) _Pragma("unroll") for (int s = 0; s < 2; ++s) { VA[db][s][0] = *(const s16x4*)(vp_ + (size_t)db * 32 * M + 16 * s); VA[db][s][1] = *(const s16x4*)(vp_ + (size_t)db * 32 * M + 16 * s + 8); } } while (0)
        ATT_LOAD(kf, va, t0);
        for (int kt = t0 >> 5; kt >= 0; --kt) {
            const int s0 = kt * 32;
            bf16x8 kn[4]; s16x4 vn[2][2][2];
            { const int sn = kt > 0 ? s0 - 32 : 0; ATT_LOAD(kn, vn, sn); }
            f32x16 X;
#pragma unroll
            for (int i = 0; i < 16; ++i) X[i] = 0.f;
#pragma unroll
            for (int d0 = 0; d0 < 4; ++d0) X = MFMA32(kf[d0], qf[d0], X);
            const bool diag = (s0 == t0);
            float Rr[16], Be[16], A[16];
#pragma unroll
            for (int i = 0; i < 16; ++i) { const float z = fminf(X[i], 100.f); const float E = __builtin_amdgcn_exp2f(z); float rr = __builtin_amdgcn_rcpf(1.f + E); float be = E * rr;
                if (diag) { const bool valid = crow(i, h) < r; be = valid ? be : 0.f; rr = valid ? rr : 1.f; }
                Rr[i] = rr; Be[i] = be; }
            float gp[4], og[4];
#pragma unroll
            for (int g = 0; g < 4; ++g) { gp[g] = (Rr[4 * g] * Rr[4 * g + 1]) * (Rr[4 * g + 2] * Rr[4 * g + 3]); og[g] = __shfl_xor(gp[g], 32); }
            float sp = carry;
#pragma unroll
            for (int g = 3; g >= 0; --g) { const float gs = (h == 0) ? sp * og[g] : sp;
                const float s3 = gs, s2 = s3 * Rr[4 * g + 3], s1 = s2 * Rr[4 * g + 2], s0f = s1 * Rr[4 * g + 1];
                A[4 * g + 3] = Be[4 * g + 3] * s3; A[4 * g + 2] = Be[4 * g + 2] * s2; A[4 * g + 1] = Be[4 * g + 1] * s1; A[4 * g] = Be[4 * g] * s0f;
                sp *= gp[g] * og[g]; }
            carry = sp;
            bf16x8 pf[2];
#pragma unroll
            for (int s = 0; s < 2; ++s) { u32x4 p; p.x = pk2(A[8 * s], A[8 * s + 1]); p.y = pk2(A[8 * s + 2], A[8 * s + 3]); p.z = pk2(A[8 * s + 4], A[8 * s + 5]); p.w = pk2(A[8 * s + 6], A[8 * s + 7]); pf[s] = __builtin_bit_cast(bf16x8, p); }
#pragma unroll
            for (int s = 0; s < 2; ++s) {
                const bf16x8 v0 = __builtin_shufflevector(va[0][s][0], va[0][s][1], 0, 1, 2, 3, 4, 5, 6, 7);
                const bf16x8 v1 = __builtin_shufflevector(va[1][s][0], va[1][s][1], 0, 1, 2, 3, 4, 5, 6, 7);
                o0 = MFMA32(pf[s], v0, o0); o1 = MFMA32(pf[s], v1, o1); }
            if (__builtin_amdgcn_ballot_w64(carry >= 1.17549435e-38f) == 0ull) break;
#pragma unroll
            for (int d0 = 0; d0 < 4; ++d0) kf[d0] = kn[d0];
#pragma unroll
            for (int db = 0; db < 2; ++db)
#pragma unroll
                for (int s = 0; s < 2; ++s) { va[db][s][0] = vn[db][s][0]; va[db][s][1] = vn[db][s][1]; }
        }
#undef ATT_LOAD
        bf16_t* op = O + (rowb + t0) * D + hh * HD + r;
#pragma unroll
        for (int i = 0; i < 16; ++i) { const size_t ro = (size_t)crow(i, h) * D; op[ro] = f2bf(o0[i]); op[ro + 32] = f2bf(o1[i]); }
    }
}

__device__ __forceinline__ void sgu_mix_phase(LAS unsigned char* lds, const float* wsj, const float* bsj, const float* gainj, const float* vstat, const bf16_t* __restrict__ VT2, bf16_t* UY) {
    OPAQUE_IDS();
    const int r = lane & 31, h = lane >> 5;
    constexpr int ROWB = 272;
    for (int u = vcu; u < BATCH * (SEQ / SC) * SG; u += G) {
        const int g = u & 7, bn = u >> 3;
        const size_t tok0 = (size_t)bn * SC;
        { const int c4 = (tid & 31) * 4; f32x4 rs;
#pragma unroll
          for (int e = 0; e < 4; ++e) { const f32x4* sp = (const f32x4*)(vstat + (tok0 + c4 + e) * 16); const f32x4 q = (sp[0] + sp[1]) + (sp[2] + sp[3]);
              rs[e] = __builtin_amdgcn_rsqf(((q[0] + q[1]) + (q[2] + q[3])) * (1.f / SF) + EPS); }
          const float* wsg = wsj + (size_t)g * SC * SC;
#pragma unroll
          for (int it = 0; it < 8; ++it) { const int t = (tid >> 5) + 16 * it; const f32x4 w = *(const f32x4*)(wsg + t * SC + c4);
              const float a0 = (c4 + 0 <= t) ? w[0] * rs[0] : 0.f, a1 = (c4 + 1 <= t) ? w[1] * rs[1] : 0.f, a2 = (c4 + 2 <= t) ? w[2] * rs[2] : 0.f, a3 = (c4 + 3 <= t) ? w[3] * rs[3] : 0.f;
              u32x2 p; p.x = pk2(a0, a1); p.y = pk2(a2, a3); *(LAS u32x2*)(lds + t * ROWB + c4 * 2) = p; } }
        __syncthreads();
        const int c0 = g * SGW + wave * 32;
        bf16x8 vb[8];
        { const bf16_t* vp = VT2 + (size_t)(c0 + r) * M + tok0 + h * 8;
#pragma unroll
          for (int ks = 0; ks < 8; ++ks) vb[ks] = *(const bf16x8*)(vp + ks * 16); }
        const float gn = gainj[c0 + r];
#pragma unroll
        for (int tb = 0; tb < 4; ++tb) {
            f32x16 acc;
#pragma unroll
            for (int i = 0; i < 16; ++i) acc[i] = 0.f;
#pragma unroll
            for (int ks = 0; ks < 2 * tb + 2; ++ks) { const bf16x8 af = *(const LAS bf16x8*)(lds + (tb * 32 + r) * ROWB + (ks * 16 + h * 8) * 2); acc = MFMA32(af, vb[ks], acc); }
#pragma unroll
            for (int i = 0; i < 16; ++i) { const int t = tb * 32 + crow(i, h); const size_t idx = (tok0 + t) * SF + c0 + r;
                const float y = bf2f(UY[idx]) * (gn * acc[i] + bsj[g * SC + t]); UY[idx] = f2bf(y); }
        }
        __syncthreads();
    }
}

__global__ void __launch_bounds__(512, 2) fwd_megakernel(Args a) {
    extern __shared__ __attribute__((aligned(16))) unsigned char lds_raw[];
    cg::grid_group grid = cg::this_grid();
    LAS unsigned char* lds = (LAS unsigned char*)lds_raw;
    const int G = gridDim.x, bx = blockIdx.x;
    unsigned char* ws = a.ws;
    float* stat = (float*)(ws + WS_STAT);
    bf16_t* XB = (bf16_t*)(ws + WS_XB);
    bf16_t* BIG = (bf16_t*)(ws + WS_BIG);
    bf16_t* Qb = BIG; bf16_t* Kb = BIG + (size_t)M * D; bf16_t* VT = BIG + 2 * (size_t)M * D; bf16_t* Ob = BIG + 3 * (size_t)M * D;
    bf16_t* UY = BIG; bf16_t* VT2 = BIG + (size_t)M * SF; bf16_t* Hb = BIG;

#ifndef NO_P0
    p0_prologue(a, lds);
#endif
    grid.sync();

#pragma unroll 1
    for (int i = 0; i < DEPTH; ++i) {
        const int j = i >> 1;
        const float* stat_in = stat + (size_t)(2 * i) * STAT_ELEMS; float* stat_mid = stat + (size_t)(2 * i + 1) * STAT_ELEMS; float* stat_out = stat + (size_t)(2 * i + 2) * STAT_ELEMS;
        const float* resbase = (i == 0) ? a.in[0] : a.out;
        if ((i & 1) == 0) {
            const bf16_t* Wqkv = (const bf16_t*)(ws + WS_WQKV) + (size_t)j * 3 * D * D;
            { pg8::Gemm g{XB, Wqkv, M, 2 * D, D}; pg8::StaticOrder S; S.init(M, 2 * D, G, bx);
              pg8::EpiRow<0> E{Qb, D, stat_in, 1.f / D, D, (size_t)M * D, QSCALE};
              pg8::gemm_phase<pg8::EpiRow<0>, pg8::StaticOrder, true, true>(lds, g, S, E); }
            { pg8::Gemm g{Wqkv + (size_t)2 * D * D, XB, D, M, D}; pg8::StaticOrder S; S.init(D, M, G, bx);
              pg8::EpiCol<0, false> E{VT, (size_t)M, stat_in, 1.f / D, nullptr};
              pg8::gemm_phase<pg8::EpiCol<0, false>, pg8::StaticOrder, true, true>(lds, g, S, E); }
            grid.sync();
#ifndef NO_ATT
            attn_phase(Qb, Kb, VT, Ob);
#endif
            grid.sync();
            { pg8::Gemm g{Ob, (const bf16_t*)(ws + WS_WO) + (size_t)j * D * D, M, D, D}; pg8::StaticOrder S; S.init(M, D, G, bx);
              pg8::EpiRes E{resbase, a.out, XB, stat_mid, D};
              pg8::gemm_phase<pg8::EpiRes, pg8::StaticOrder, true, true>(lds, g, S, E); }
            grid.sync();
        } else {
            const bf16_t* Win = (const bf16_t*)(ws + WS_WIN) + (size_t)j * 2 * SF * D;
            float* vstat = stat + (size_t)(9 + j) * STAT_ELEMS;
            { pg8::Gemm g{XB, Win, M, SF, D}; pg8::StaticOrder S; S.init(M, SF, G, bx);
              pg8::EpiRow<2> E{UY, SF, stat_in, 1.f / D, 0, 0, 1.f};
              pg8::gemm_phase<pg8::EpiRow<2>, pg8::StaticOrder, true, true>(lds, g, S, E); }
            { pg8::Gemm g{Win + (size_t)SF * D, XB, SF, M, D}; pg8::StaticOrder S; S.init(SF, M, G, bx);
              pg8::EpiCol<2, true> E{VT2, (size_t)M, stat_in, 1.f / D, vstat};
              pg8::gemm_phase<pg8::EpiCol<2, true>, pg8::StaticOrder, true, true>(lds, g, S, E); }
            grid.sync();
#ifndef NO_MIX
            sgu_mix_phase(lds, a.in[7] + (size_t)j * SG * SC * SC, a.in[8] + (size_t)j * SG * SC, a.in[6] + (size_t)j * SF, vstat, VT2, UY);
#endif
            grid.sync();
            { pg8::Gemm g{UY, (const bf16_t*)(ws + WS_WOUT) + (size_t)j * D * SF, M, D, SF}; pg8::StaticOrder S; S.init(M, D, G, bx);
              pg8::EpiRes E{resbase, a.out, XB, stat_mid, D};
              pg8::gemm_phase<pg8::EpiRes, pg8::StaticOrder, true, true>(lds, g, S, E); }
            grid.sync();
        }
        { pg8::Gemm g{XB, (const bf16_t*)(ws + WS_W1) + (size_t)i * FF * D, M, FF, D}; pg8::StaticOrder S; S.init(M, FF, G, bx);
          pg8::EpiRow<1> E{Hb, FF, stat_mid, 1.f / D, 0, 0, 1.f};
          pg8::gemm_phase<pg8::EpiRow<1>, pg8::StaticOrder, true, true>(lds, g, S, E); }
        grid.sync();
        { pg8::Gemm g{Hb, (const bf16_t*)(ws + WS_W2) + (size_t)i * D * FF, M, D, FF}; pg8::StaticOrder S; S.init(M, D, G, bx);
          pg8::EpiRes E{a.out, a.out, XB, stat_out, D};
          pg8::gemm_phase<pg8::EpiRes, pg8::StaticOrder, true, true>(lds, g, S, E); }
        grid.sync();
    }
    { OPAQUE_IDS(); const float* st = stat + (size_t)8 * STAT_ELEMS; const f32x4* gn = (const f32x4*)a.in[12] + lane; const int gw = vcu * 8 + wave, NGW = G * 8;
      f32x4 gv[4];
#pragma unroll
      for (int jj = 0; jj < 4; ++jj) gv[jj] = gn[64 * jj];
      for (int m = gw; m < M; m += NGW) { f32x4* xr = (f32x4*)(a.out + (size_t)m * D) + lane; const float rs = __builtin_amdgcn_rsqf(wave_sum(lane < 16 ? st[(size_t)m * 16 + lane] : 0.f) * (1.f / D) + EPS);
#pragma unroll
          for (int jj = 0; jj < 4; ++jj) { f32x4 v = xr[64 * jj]; xr[64 * jj] = v * rs * gv[jj]; } } }
}

extern "C" void kernel_launch(void* const* d_in, const int* in_sizes, int n_in, void* d_out, int out_size, void* d_ws, size_t ws_size, hipStream_t stream) {
    static int grid = 0;
    if (grid == 0) {
        if (n_in != 13 || in_sizes[0] != M * D || out_size != M * D || ws_size < WS_END) { fprintf(stderr, "kernel_launch: unexpected shapes (n_in %d, in0 %d, out %d, ws %zu)\n", n_in, n_in > 0 ? in_sizes[0] : -1, out_size, ws_size); grid = -1; return; }
        int dev = 0, cus = 0, per_cu = 0;
        if (hipGetDevice(&dev) != hipSuccess || hipDeviceGetAttribute(&cus, hipDeviceAttributeMultiprocessorCount, dev) != hipSuccess) { grid = -1; return; }
        if (hipFuncSetAttribute((const void*)fwd_megakernel, hipFuncAttributeMaxDynamicSharedMemorySize, LDS_BYTES) != hipSuccess) { fprintf(stderr, "kernel_launch: hipFuncSetAttribute failed\n"); grid = -1; return; }
        if (hipOccupancyMaxActiveBlocksPerMultiprocessor(&per_cu, (const void*)fwd_megakernel, 512, LDS_BYTES) != hipSuccess || per_cu < 1) { fprintf(stderr, "kernel_launch: occupancy query says %d\n", per_cu); per_cu = 1; }
        (void)hipGetLastError();
        grid = cus;
    }
    if (grid < 0) return;
    Args a{};
    for (int i = 0; i < 13; ++i) a.in[i] = (const float*)d_in[i];
    a.out = (float*)d_out; a.ws = (unsigned char*)d_ws;
    void* args[] = {&a};
    hipError_t e = hipLaunchCooperativeKernel((const void*)fwd_megakernel, dim3(grid), dim3(512), args, LDS_BYTES, stream);
    if (e != hipSuccess) fprintf(stderr, "kernel_launch: cooperative launch failed: %s (grid %d)\n", hipGetErrorString(e), grid);
}
```

```cpp
#define PG_WGM 4
#include <hip/hip_runtime.h>
#include <hip/hip_cooperative_groups.h>
#include <cstdio>
#include <cstdint>
namespace cg = cooperative_groups;
#ifndef PG_WGM
#define PG_WGM 8
#endif
namespace pg8 {
#define PG8_LAS __attribute__((address_space(3)))
typedef unsigned short bf16_t;
typedef short bf16x8 __attribute__((ext_vector_type(8)));
typedef float f32x4 __attribute__((ext_vector_type(4)));
typedef unsigned u32x4 __attribute__((ext_vector_type(4)));
constexpr int BM = 256, BK = 64, HALF = 128, HTB = HALF * BK * 2  , STAGE_BYTES = 8 * HTB, NXCD = 8, WGM = PG_WGM;

__host__ __device__ __forceinline__ int lds_byte(int r, int c) { const int st = (r >> 4) * 2 + (c >> 5), rr = r & 15, cc = c & 31, ob = rr * 64 + cc * 2; return st * 1024 + (ob ^ (((ob >> 9) & 1) << 5)); }
__host__ __device__ __forceinline__ void stage_rc(int b, int& R, int& C) { const int st = b / 1024, sb = b % 1024, swz = sb ^ (((sb >> 9) & 1) << 5); R = (st >> 1) * 16 + swz / 64; C = (st & 1) * 32 + (swz % 64) / 2; }
__host__ __device__ __forceinline__ int perm32(int rho) { const int n = rho >> 4, i = rho & 15; return 8 * (i >> 2) + 4 * n + (i & 3); }

struct Unit { int pm, pn; };
struct Gemm { const bf16_t* A; const bf16_t* Bt; int M, N, K; };

struct StaticOrder {
    int nM, nN, nwg, G, c;
    __host__ __device__ void init(int M, int N, int G_, int c_) { nM = M / BM; nN = N / BM; nwg = nM * nN; G = G_; c = c_; }
    __host__ __device__ bool next(int i, Unit& u) const {
        const long L = (long)i * G + c; if (L >= nwg) return false;
        int wgid = (int)L; { const int q = nwg / NXCD, r = nwg % NXCD, xcd = wgid % NXCD, off = wgid / NXCD; wgid = (xcd < r ? xcd * (q + 1) : r * (q + 1) + (xcd - r) * q) + off; }
        const int nig = WGM * nN, gid = wgid / nig, fm = gid * WGM, gsz = (nM - fm) < WGM ? (nM - fm) : WGM;
        u.pm = fm + ((wgid % nig) % gsz); u.pn = (wgid % nig) / gsz; return true;
    }
    __device__ __forceinline__ void a_ready(const Unit&) const {}
    __device__ __forceinline__ void done(const Unit&) const {}
};

typedef float f32x2_t __attribute__((ext_vector_type(2))); typedef __bf16 bf16x2_t __attribute__((ext_vector_type(2))); typedef unsigned u32x2 __attribute__((ext_vector_type(2)));
__device__ __forceinline__ unsigned pk2(float lo, float hi) { f32x2_t v = {lo, hi}; bf16x2_t b = __builtin_convertvector(v, bf16x2_t); return __builtin_bit_cast(unsigned, b); }
constexpr float NORM_EPS = 1e-6f;
#ifndef RELAX_DEFAULT
#define RELAX_DEFAULT false
#endif
#if 1
#define ST16(p, v) __builtin_nontemporal_store((v), (u32x4*)(p))
#define ST8(p, v) __builtin_nontemporal_store((v), (u32x2*)(p))
#else
#define ST16(p, v) (*(u32x4*)(p) = (v))
#define ST8(p, v) (*(u32x2*)(p) = (v))
#endif
#if 1
#define ST16L(p, v) __builtin_nontemporal_store((v), (u32x4*)(p))
#else
#define ST16L(p, v) ST16R(p, v)
#endif
#ifdef NT_RESLD
#define LD16R(p) __builtin_nontemporal_load((const u32x4*)(p))
#else
#define LD16R(p) (*(const u32x4*)(p))
#endif
#ifdef NT_RES
#define ST16R(p, v) __builtin_nontemporal_store((v), (u32x4*)(p))
#else
#define ST16R(p, v) (*(u32x4*)(p) = (v))
#endif
template <int ACT> __device__ __forceinline__ float act_fn(float x) {
    if (ACT == 1) { const float v = fmaxf(x, 0.f); return v * v; }
    if (ACT == 2) { const float e = __builtin_amdgcn_exp2f(-2.302208198f * x * (1.f + 0.044715f * x * x)); return x * __builtin_amdgcn_rcpf(1.f + e); }
    return x;
}
template <int ACT, bool TILED = false> struct EpiRow {
    static constexpr bool PERM = true, AFTER_DRAIN = false, RELAX_OK = RELAX_DEFAULT;
    bf16_t* O; int ldc; const float* stat; float inv_n; int split_cols; size_t split_stride; float scale0;
    template <class Sched> __device__ __forceinline__ void prepare(PG8_LAS float* tab, const Sched& S, int tid) const {
        Unit u;
#pragma unroll 4
        for (int ui = 0; S.next(ui, u); ++ui) { const f32x4* sp = (const f32x4*)(stat + (size_t)(u.pm * BM + (tid >> 1)) * 16 + (tid & 1) * 8); const f32x4 q = sp[0] + sp[1];
            float s = (q[0] + q[1]) + (q[2] + q[3]); s += __shfl_xor(s, 1); if (!(tid & 1)) tab[ui * 256 + (tid >> 1)] = __builtin_amdgcn_rsqf(s * inv_n + NORM_EPS); }
    }
    __device__ __forceinline__ void operator()(const f32x4 (&acc)[2][2][4][2], const Unit& u, int wr, int wc, int fr, int fq, int ui, const PG8_LAS float* tab) const {
        const int row0 = u.pm * BM + wr * 64 + fr; int colt = u.pn * BM; bf16_t* base = O; float sc = 1.f;
        if (split_cols) { const int t = colt / split_cols; base += (size_t)t * split_stride; colt -= t * split_cols; if (t == 0) sc = scale0; }
        const int col0 = colt + wc * 32 + 8 * fq;
#pragma unroll
        for (int ai = 0; ai < 2; ++ai)
#pragma unroll
            for (int m = 0; m < 4; ++m) { const int row = row0 + ai * HALF + m * 16; const float rs = tab[ui * 256 + ai * HALF + wr * 64 + m * 16 + fr];
                bf16_t* rowp = base + (size_t)row * ldc + col0;
#pragma unroll
                for (int bj = 0; bj < 2; ++bj) { f32x4 v0 = acc[ai][bj][m][0] * rs, v1 = acc[ai][bj][m][1] * rs;
#pragma unroll
                    for (int e = 0; e < 4; ++e) { v0[e] = act_fn<ACT>(v0[e]) * sc; v1[e] = act_fn<ACT>(v1[e]) * sc; }
                    u32x4 w; w.x = pk2(v0[0], v0[1]); w.y = pk2(v0[2], v0[3]); w.z = pk2(v1[0], v1[1]); w.w = pk2(v1[2], v1[3]);
                    if (TILED) { const int c = col0 + bj * HALF, hd = c >> 6, d = c & 63, b = row >> 11, sq = row & 2047, kt = sq >> 5, r = sq & 31;
                        ST16(base + ((size_t)(((b * 16 + hd) * 64 + kt)) << 11) + (d >> 4) * 512 + (((d >> 3) & 1) * 32 + r) * 8, w); }
                    else ST16(rowp + bj * HALF, w); } }
    }
};
template <int V> struct EpiVar {
    static constexpr bool PERM = true, AFTER_DRAIN = false, RELAX_OK = false;
    bf16_t* O; int ldc; const float* stat; float inv_n;
    template <class Sched> __device__ __forceinline__ void prepare(PG8_LAS float*, const Sched&, int) const {}
    __device__ __forceinline__ void operator()(const f32x4 (&acc)[2][2][4][2], const Unit& u, int wr, int wc, int fr, int fq, int ui, const PG8_LAS float* tab) const {
        if (V == 3) return;
        const int row0 = u.pm * BM + wr * 64 + fr; const int col0 = u.pn * BM + wc * 32 + 8 * fq;
#pragma unroll
        for (int ai = 0; ai < 2; ++ai)
#pragma unroll
            for (int m = 0; m < 4; ++m) { const int row = row0 + ai * HALF + m * 16; float rs = 1.f;
                if (V != 1) { const f32x4 p4 = *(const f32x4*)(stat + (size_t)row * 16 + 4 * fq); float s = (p4[0] + p4[1]) + (p4[2] + p4[3]); s += __shfl_xor(s, 16); s += __shfl_xor(s, 32); rs = __builtin_amdgcn_rsqf(s * inv_n + NORM_EPS); }
                bf16_t* rowp = O + (size_t)row * ldc + col0;
#pragma unroll
                for (int bj = 0; bj < 2; ++bj) { f32x4 v0 = acc[ai][bj][m][0] * rs, v1 = acc[ai][bj][m][1] * rs;
#pragma unroll
                    for (int e = 0; e < 4; ++e) { v0[e] = act_fn<1>(v0[e]); v1[e] = act_fn<1>(v1[e]); }
                    u32x4 w; w.x = pk2(v0[0], v0[1]); w.y = pk2(v0[2], v0[3]); w.z = pk2(v1[0], v1[1]); w.w = pk2(v1[2], v1[3]);
                    if (V != 2 || w.x == 0x7fc17fc1u) *(u32x4*)(rowp + bj * HALF) = w; } }
    }
};
template <int ACT, bool VSTAT, bool TILED = false> struct EpiCol {
    static constexpr bool PERM = true, AFTER_DRAIN = false, RELAX_OK = RELAX_DEFAULT;
    bf16_t* O; size_t ldc; const float* stat; float inv_n; float* vstat;
    template <class Sched> __device__ __forceinline__ void prepare(PG8_LAS float* tab, const Sched& S, int tid) const {
        Unit u;
#pragma unroll 4
        for (int ui = 0; S.next(ui, u); ++ui) { const f32x4* sp = (const f32x4*)(stat + (size_t)(u.pn * BM + (tid >> 1)) * 16 + (tid & 1) * 8); const f32x4 q = sp[0] + sp[1];
            float s = (q[0] + q[1]) + (q[2] + q[3]); s += __shfl_xor(s, 1); if (!(tid & 1)) tab[ui * 256 + (tid >> 1)] = __builtin_amdgcn_rsqf(s * inv_n + NORM_EPS); }
    }
    __device__ __forceinline__ void operator()(const f32x4 (&acc)[2][2][4][2], const Unit& u, int wr, int wc, int fr, int fq, int ui, const PG8_LAS float* tab) const {
        const int row0 = u.pm * BM + wr * 64 + fr; const int col0 = u.pn * BM + wc * 32 + 8 * fq;
        f32x4 rsv[2][2], sq[2][2];
#pragma unroll
        for (int bj = 0; bj < 2; ++bj)
#pragma unroll
            for (int n = 0; n < 2; ++n) { rsv[bj][n] = *(const PG8_LAS f32x4*)(tab + ui * 256 + wc * 32 + 8 * fq + bj * HALF + 4 * n); sq[bj][n] = (f32x4){0.f, 0.f, 0.f, 0.f}; }
#pragma unroll
        for (int ai = 0; ai < 2; ++ai)
#pragma unroll
            for (int m = 0; m < 4; ++m) { bf16_t* rowp = O + (size_t)(row0 + ai * HALF + m * 16) * ldc + col0;
#pragma unroll
                for (int bj = 0; bj < 2; ++bj) { f32x4 v0 = acc[ai][bj][m][0] * rsv[bj][0], v1 = acc[ai][bj][m][1] * rsv[bj][1];
#pragma unroll
                    for (int e = 0; e < 4; ++e) { v0[e] = act_fn<ACT>(v0[e]); v1[e] = act_fn<ACT>(v1[e]); }
                    if (VSTAT) { sq[bj][0] += v0 * v0; sq[bj][1] += v1 * v1; }
                    u32x4 w; w.x = pk2(v0[0], v0[1]); w.y = pk2(v0[2], v0[3]); w.z = pk2(v1[0], v1[1]); w.w = pk2(v1[2], v1[3]);
                    if (TILED) { const int ch = row0 + ai * HALF + m * 16, hd = ch >> 6, d = ch & 63, tk = col0 + bj * HALF, b = tk >> 11, sq = tk & 2047, kt = sq >> 5, k0 = sq & 31;
                        bf16_t* tp = O + ((size_t)(((b * 16 + hd) * 64 + kt)) << 11) + ((((d >> 5) * 2 + (k0 >> 4)) * 2 + ((k0 >> 3) & 1)) * 256) + (d & 31) * 4;
                        u32x2 lo, hi; lo.x = w.x; lo.y = w.y; hi.x = w.z; hi.y = w.w; ST8(tp, lo); ST8(tp + 128, hi); }
                    else ST16(rowp + bj * HALF, w); } }
        if (VSTAT) {
#pragma unroll
            for (int bj = 0; bj < 2; ++bj)
#pragma unroll
                for (int n = 0; n < 2; ++n)
#pragma unroll
                    for (int e = 0; e < 4; ++e) { float s = sq[bj][n][e]; s += __shfl_xor(s, 1); s += __shfl_xor(s, 2); s += __shfl_xor(s, 4); s += __shfl_xor(s, 8);
                        if (fr == bj * 8 + n * 4 + e) vstat[(size_t)(col0 + bj * HALF + 4 * n + e) * 16 + u.pm * 2 + wr] = s; }
        }
    }
};
#ifndef RES_LO
#define RES_LO 0
#endif
struct EpiRes {
    static constexpr bool PERM = true, AFTER_DRAIN = false, RELAX_OK = RELAX_DEFAULT;
    bf16_t* xb; bf16_t* xl; float* stat; int ldc;
    template <class Sched> __device__ __forceinline__ void prepare(PG8_LAS float*, const Sched&, int) const {}
    __device__ __forceinline__ void operator()(const f32x4 (&acc)[2][2][4][2], const Unit& u, int wr, int wc, int fr, int fq, int ui, const PG8_LAS float* tab) const {
        const int row0 = u.pm * BM + wr * 64 + fr; const int col0 = u.pn * BM + wc * 32 + 8 * fq;
#pragma unroll
        for (int ai = 0; ai < 2; ++ai) {
            u32x4 bh[4][2], bl[4][2];
#pragma unroll
            for (int m = 0; m < 4; ++m) { const size_t off = (size_t)(row0 + ai * HALF + m * 16) * ldc + col0;
#pragma unroll
                for (int bj = 0; bj < 2; ++bj) { bh[m][bj] = LD16R(xb + off + bj * HALF); bl[m][bj] = RES_LO ? LD16R(xl + off + bj * HALF) : (u32x4){0u, 0u, 0u, 0u}; } }
#pragma unroll
            for (int m = 0; m < 4; ++m) { const int row = row0 + ai * HALF + m * 16; const size_t off = (size_t)row * ldc + col0; float ss = 0.f;
#pragma unroll
                for (int bj = 0; bj < 2; ++bj) { const u32x4 h4 = bh[m][bj], l4 = bl[m][bj]; u32x4 wh, wl;
#pragma unroll
                    for (int e = 0; e < 4; ++e) { const int n = e >> 1, k = (e & 1) * 2;
                        const float x0 = __uint_as_float(h4[e] << 16) + __uint_as_float(l4[e] << 16) + acc[ai][bj][m][n][k];
                        const float x1 = __uint_as_float(h4[e] & 0xffff0000u) + __uint_as_float(l4[e] & 0xffff0000u) + acc[ai][bj][m][n][k + 1];
                        ss += x0 * x0 + x1 * x1;
                        const unsigned hw = pk2(x0, x1); wh[e] = hw;
                        wl[e] = pk2(x0 - __uint_as_float(hw << 16), x1 - __uint_as_float(hw & 0xffff0000u)); }
                    ST16R(xb + off + bj * HALF, wh); if (RES_LO) ST16L(xl + off + bj * HALF, wl); }
                ss += __shfl_xor(ss, 16); ss += __shfl_xor(ss, 32);
                if (fq == 0) stat[(size_t)row * 16 + u.pn * 4 + wc] = ss; }
        }
    }
};

template <class Epi, class Sched, bool ALIGN_EPI = false, bool SP2 = false>
__device__ __forceinline__ void gemm_phase(PG8_LAS unsigned char* lds, const Gemm g, const Sched& S0, const Epi& E) {
    PG8_LAS float* tab = (PG8_LAS float*)(lds + STAGE_BYTES + 1024);
    Sched S = S0; asm volatile("" : "+s"(S.c));
    int tid_ = threadIdx.x, K_ = g.K; asm volatile("" : "+v"(tid_), "+s"(K_));
    const int tid = tid_, wid = __builtin_amdgcn_readfirstlane(tid >> 6), lane = tid & 63, wr = wid >> 2, wc = wid & 3, fr = lane & 15, fq = lane >> 4;
    const int K = K_, nt = K / BK;
    unsigned voffA[2], voffB[2];
#pragma unroll
    for (int i = 0; i < 2; ++i) { int R, C; stage_rc(tid * 16 + i * 8192, R, C); const int Rb = Epi::PERM ? ((R & ~31) + perm32(R & 31)) : R;
        voffA[i] = (unsigned)(R * K + C) * 2u; voffB[i] = (unsigned)(Rb * K + C) * 2u; }
    const size_t kstep = (size_t)(BK * 2);
    const size_t hstep = (size_t)HALF * K * 2;
    const size_t tstep = 2 * hstep;
    const unsigned ldsw = (unsigned)wid * 1024u;
    const int aoff = lds_byte(wr * 64 + fr, fq * 8), boff = lds_byte(wc * 32 + fr, fq * 8);
#define PG8_SA(b, h) (((b) * 2 + (h)) * HTB)
#define PG8_SB(b, h) ((4 + (b) * 2 + (h)) * HTB)
#define PG8_STAGE(bufoff, gbase, voff) do { _Pragma("unroll") for (int _i = 0; _i < 2; ++_i) \
        __builtin_amdgcn_global_load_lds((const unsigned*)((const char*)(gbase) + (voff)[_i]), (PG8_LAS unsigned*)(lds + (bufoff) + ldsw + _i * 8192), 16, 0, 0); } while (0)
#define PG8_LDA(dst, b, h) do { _Pragma("unroll") for (int m = 0; m < 4; ++m) _Pragma("unroll") for (int k = 0; k < 2; ++k) dst[m][k] = *(const PG8_LAS bf16x8*)(lds + PG8_SA(b, h) + aoff + m * 2048 + k * 1024); } while (0)
#define PG8_LDB(dst, b, h) do { _Pragma("unroll") for (int n = 0; n < 2; ++n) _Pragma("unroll") for (int k = 0; k < 2; ++k) dst[n][k] = *(const PG8_LAS bf16x8*)(lds + PG8_SB(b, h) + boff + n * 2048 + k * 1024); } while (0)
#define PG8_MMA(ai, bj, At, Bt) do { __builtin_amdgcn_s_setprio(1); _Pragma("unroll") for (int m = 0; m < 4; ++m) _Pragma("unroll") for (int n = 0; n < 2; ++n) _Pragma("unroll") for (int k = 0; k < 2; ++k) \
        acc[ai][bj][m][n] = __builtin_amdgcn_mfma_f32_16x16x32_bf16(Bt[n][k], At[m][k], acc[ai][bj][m][n], 0, 0, 0); __builtin_amdgcn_s_setprio(0); } while (0)
#define PG8_WAIT_V(n) asm volatile("s_waitcnt vmcnt(" #n ")" ::: "memory")
#define PG8_WAIT_L(n) asm volatile("s_waitcnt lgkmcnt(" #n ")" ::: "memory")
#define PG8_BAR __builtin_amdgcn_s_barrier()
#define PG8_SCHED __builtin_amdgcn_sched_barrier(0)
    Unit cur, nxt; int ui = 0;
    if (!S.next(0, cur)) return;
    E.prepare(tab, S, tid); __syncthreads();
    f32x4 acc[2][2][4][2];
#pragma unroll
    for (int a = 0; a < 2; ++a)
#pragma unroll
        for (int b = 0; b < 2; ++b)
#pragma unroll
            for (int m = 0; m < 4; ++m)
#pragma unroll
                for (int n = 0; n < 2; ++n) acc[a][b][m][n] = (f32x4){0.f, 0.f, 0.f, 0.f};
    bf16x8 At[4][2], B0[2][2], B1[2][2];
    const char* cA = (const char*)g.A + (size_t)cur.pm * tstep; const char* cB = (const char*)g.Bt + (size_t)cur.pn * tstep;
    S.a_ready(cur);
    if constexpr (SP2) {
        PG8_STAGE(PG8_SB(0, 0), cB, voffB); PG8_STAGE(PG8_SB(0, 1), cB + hstep, voffB); PG8_STAGE(PG8_SA(0, 0), cA, voffA); PG8_STAGE(PG8_SA(0, 1), cA + hstep, voffA);
        if (wr == 1) PG8_BAR;
        PG8_WAIT_V(2); PG8_BAR;
        PG8_STAGE(PG8_SB(1, 0), cB + kstep, voffB); PG8_STAGE(PG8_SA(1, 0), cA + kstep, voffA); PG8_STAGE(PG8_SB(1, 1), cB + hstep + kstep, voffB);
        PG8_WAIT_V(6); PG8_BAR;
    } else {
        PG8_STAGE(PG8_SB(0, 0), cB, voffB); PG8_STAGE(PG8_SA(0, 0), cA, voffA); PG8_STAGE(PG8_SB(0, 1), cB + hstep, voffB); PG8_STAGE(PG8_SA(0, 1), cA + hstep, voffA);
        if (wr == 1) PG8_BAR;
        PG8_WAIT_V(4); PG8_BAR;
        PG8_STAGE(PG8_SB(1, 0), cB + kstep, voffB); PG8_STAGE(PG8_SA(1, 0), cA + kstep, voffA); PG8_STAGE(PG8_SB(1, 1), cB + hstep + kstep, voffB);
        PG8_WAIT_V(6); PG8_BAR;
    }
    for (;;) {
        const bool has_next = S.next(ui + 1, nxt);
        const char* nA = has_next ? (const char*)g.A + (size_t)nxt.pm * tstep : cA; const char* nB = has_next ? (const char*)g.Bt + (size_t)nxt.pn * tstep : cB;
        for (int t = 0; t < nt; t += 2) {
            const bool last = (t == nt - 2);
            const char* a1 = cA + (size_t)(t + 1) * kstep;
            const char* a2 = last ? nA : cA + (size_t)(t + 2) * kstep; const char* b2 = last ? nB : cB + (size_t)(t + 2) * kstep;
            const char* a3 = a2 + kstep; const char* b3 = b2 + kstep;
            if (last && has_next) S.a_ready(nxt);
            if constexpr (SP2) {
            const int relax = __builtin_amdgcn_readfirstlane((Epi::RELAX_OK && (t == 0) && (ui > 0)) ? 1 : 0);
            PG8_LDB(B0, 0, 0); PG8_LDB(B1, 0, 1); PG8_SCHED; PG8_LDA(At, 0, 0); PG8_STAGE(PG8_SA(1, 1), a1 + hstep, voffA);
            asm volatile("s_cmp_lg_u32 %0, 0\n\ts_cbranch_scc1 1\n\ts_waitcnt vmcnt(8)" :: "s"(relax) : "memory", "scc");
            PG8_WAIT_L(0); PG8_BAR; PG8_MMA(0, 0, At, B0); PG8_MMA(0, 1, At, B1); PG8_BAR; PG8_SCHED;
            PG8_LDA(At, 0, 1); PG8_STAGE(PG8_SB(0, 0), b2, voffB); PG8_STAGE(PG8_SB(0, 1), b2 + hstep, voffB); PG8_STAGE(PG8_SA(0, 0), a2, voffA);
            asm volatile("s_cmp_lg_u32 %0, 0\n\ts_cbranch_scc1 1\n\ts_waitcnt vmcnt(8)" :: "s"(relax) : "memory", "scc");
            PG8_WAIT_L(0); PG8_BAR; PG8_MMA(1, 0, At, B0); PG8_MMA(1, 1, At, B1); PG8_BAR; PG8_SCHED;
            PG8_LDB(B0, 1, 0); PG8_LDB(B1, 1, 1); PG8_SCHED; PG8_LDA(At, 1, 0); PG8_STAGE(PG8_SA(0, 1), a2 + hstep, voffA);
            PG8_WAIT_V(8); PG8_WAIT_L(0); PG8_BAR; PG8_MMA(0, 0, At, B0); PG8_MMA(0, 1, At, B1); PG8_BAR; PG8_SCHED;
            PG8_LDA(At, 1, 1); PG8_STAGE(PG8_SB(1, 0), b3, voffB); PG8_STAGE(PG8_SB(1, 1), b3 + hstep, voffB); PG8_STAGE(PG8_SA(1, 0), a3, voffA);
            PG8_WAIT_V(8); PG8_WAIT_L(0); PG8_BAR; PG8_MMA(1, 0, At, B0); PG8_MMA(1, 1, At, B1); PG8_BAR; PG8_SCHED;
            } else {
            PG8_LDB(B0, 0, 0); PG8_SCHED; PG8_LDA(At, 0, 0); PG8_STAGE(PG8_SA(1, 1), a1 + hstep, voffA);
            PG8_WAIT_L(8); PG8_BAR; PG8_WAIT_L(0); PG8_MMA(0, 0, At, B0); PG8_BAR; PG8_SCHED;
            PG8_LDB(B1, 0, 1); PG8_STAGE(PG8_SB(0, 0), b2, voffB);
            PG8_BAR; PG8_WAIT_L(0); PG8_MMA(0, 1, At, B1); PG8_BAR;
            PG8_LDA(At, 0, 1); PG8_STAGE(PG8_SA(0, 0), a2, voffA);
            PG8_BAR; PG8_WAIT_L(0); PG8_MMA(1, 0, At, B0); PG8_BAR; PG8_SCHED;
            PG8_STAGE(PG8_SB(0, 1), b2 + hstep, voffB);
            PG8_WAIT_V(6); PG8_BAR; PG8_MMA(1, 1, At, B1); PG8_BAR;
            PG8_LDB(B0, 1, 0); PG8_SCHED; PG8_LDA(At, 1, 0); PG8_STAGE(PG8_SA(0, 1), a2 + hstep, voffA);
            PG8_WAIT_L(8); PG8_BAR; PG8_WAIT_L(0); PG8_MMA(0, 0, At, B0); PG8_BAR; PG8_SCHED;
            PG8_LDB(B1, 1, 1); PG8_STAGE(PG8_SB(1, 0), b3, voffB);
            PG8_BAR; PG8_WAIT_L(0); PG8_MMA(0, 1, At, B1); PG8_BAR;
            PG8_LDA(At, 1, 1); PG8_STAGE(PG8_SA(1, 0), a3, voffA);
            PG8_BAR; PG8_WAIT_L(0); PG8_MMA(1, 0, At, B0); PG8_BAR; PG8_SCHED;
            PG8_STAGE(PG8_SB(1, 1), b3 + hstep, voffB);
            PG8_WAIT_V(6); PG8_BAR; PG8_MMA(1, 1, At, B1); PG8_BAR;
            }
        }
        if constexpr (ALIGN_EPI) { if (wr == 0) PG8_BAR; }
        if constexpr (!Epi::AFTER_DRAIN) { E(acc, cur, wr, wc, fr, fq, ui, tab); S.done(cur); }
        if (!has_next) break;
#pragma unroll
        for (int a = 0; a < 2; ++a)
#pragma unroll
            for (int b = 0; b < 2; ++b)
#pragma unroll
                for (int m = 0; m < 4; ++m)
#pragma unroll
                    for (int n = 0; n < 2; ++n) acc[a][b][m][n] = (f32x4){0.f, 0.f, 0.f, 0.f};
        cur = nxt; cA = nA; cB = nB; ++ui;
        if constexpr (ALIGN_EPI) { if (wr == 1) PG8_BAR; }
    }
    PG8_WAIT_V(0);
    if constexpr (!ALIGN_EPI) { if (wr == 0) PG8_BAR; }
    PG8_BAR;
    if constexpr (Epi::AFTER_DRAIN) { E.fused(acc, cur, wr, wc, fr, fq, lds, wid, lane); S.done(cur); }
#undef PG8_SA
#undef PG8_SB
#undef PG8_STAGE
#undef PG8_LDA
#undef PG8_LDB
#undef PG8_MMA
#undef PG8_WAIT_V
#undef PG8_WAIT_L
#undef PG8_BAR
#undef PG8_SCHED
}
}
#define LAS __attribute__((address_space(3)))
typedef unsigned short bf16_t;
typedef short bf16x8 __attribute__((ext_vector_type(8)));
typedef short s16x4 __attribute__((ext_vector_type(4)));
typedef float f32x4 __attribute__((ext_vector_type(4)));
typedef float f32x16 __attribute__((ext_vector_type(16)));
typedef unsigned u32x4 __attribute__((ext_vector_type(4)));
using pg8::u32x2;
using pg8::pk2;
#ifndef PG_ALIGN
#define PG_ALIGN true
#endif
#ifndef PG_SP2
#define PG_SP2 true
#endif
#define MFMA32(a, b, c) __builtin_amdgcn_mfma_f32_32x32x16_bf16((a), (b), (c), 0, 0, 0)
#define LDS_WAIT() asm volatile("s_waitcnt lgkmcnt(0)" ::: "memory")

constexpr int BATCH = 32, SEQ = 2048, D = 1024, M = BATCH * SEQ, DEPTH = 4, NH = 16, HD = 64, FF = 4096, SF = 2048, SG = 8, SC = 128, SGW = 256;
constexpr float EPS = 1e-6f;
constexpr float QSCALE = 0.125f * 1.4426950408889634f;
constexpr size_t MiB = 1u << 20;
constexpr size_t WS_WQKV = 4 * MiB;
constexpr size_t WS_WO = 16 * MiB;
constexpr size_t WS_WIN = 20 * MiB;
constexpr size_t WS_WOUT = 36 * MiB;
constexpr size_t WS_W1 = 44 * MiB;
constexpr size_t WS_W2 = 76 * MiB;
constexpr size_t WS_XB = 112 * MiB;
constexpr size_t WS_BIG = 240 * MiB;
constexpr size_t PV = (size_t)M + 128;
constexpr size_t WS_STAT = 756 * MiB;
constexpr size_t STAT_ELEMS = (size_t)M * 16;
constexpr size_t WS_XL = 800 * MiB;
constexpr size_t WS_END = 928 * MiB;
constexpr int LDS_BYTES = 155648;

__device__ __forceinline__ int crow(int reg, int h) { return (reg & 3) + 8 * (reg >> 2) + 4 * h; }
__device__ __forceinline__ float wave_sum(float v) {
#pragma unroll
    for (int o = 1; o < 64; o <<= 1) v += __shfl_xor(v, o);
    return v;
}
__device__ __forceinline__ float bf2f(bf16_t v) { return __uint_as_float((unsigned)v << 16); }
__device__ __forceinline__ bf16_t f2bf(float v) { return (bf16_t)(pk2(v, 0.f) & 0xffffu); }

typedef __attribute__((address_space(1))) unsigned gu32;
#define XB_TMO      128
#define XB_XCNT(j)  (256  + 64 * (j))
#define XB_XSUB(j)  (1280 + 64 * (j))
#define XB_XGEN(j)  (2304 + 64 * (j))
#define XB_TOP      3328
#define XB_TOPGEN   3392
#define XCD_BAR_WORDS 3456
#define XB_SPIN_CAP (1u << 18)

__device__ __forceinline__ unsigned xb_ld(unsigned* p)              { return __hip_atomic_load(p, __ATOMIC_RELAXED, __HIP_MEMORY_SCOPE_AGENT); }
__device__ __forceinline__ unsigned xb_add(unsigned* p, unsigned v) { return __hip_atomic_fetch_add(p, v, __ATOMIC_RELAXED, __HIP_MEMORY_SCOPE_AGENT); }
__device__ __forceinline__ unsigned xb_xcc_id() { return (unsigned)__builtin_amdgcn_s_getreg((3 << 11) | 20) & 0xFu; }
#define XB_SPIN(cond, bar) do { unsigned _sp = 0; while (cond) { __builtin_amdgcn_s_sleep(1); \
    if ((++_sp & 255u) == 0u) { if (xb_ld(&(bar)[XB_TMO])) break; if (_sp > XB_SPIN_CAP) { atomicAdd(&(bar)[XB_TMO], 1u); break; } } } } while (0)

struct XcdBarrier {
    unsigned* bar; unsigned x;
    volatile LAS unsigned* st;
};

__device__ __forceinline__ XcdBarrier xcd_barrier_post(unsigned* bar, volatile LAS unsigned* st) {
    XcdBarrier b; b.bar = bar; b.x = xb_xcc_id(); b.st = st;
    if (threadIdx.x == 0) (void)xb_add(&bar[XB_XCNT(b.x)], 1u);
    return b;
}
__device__ __forceinline__ void xcd_barrier_complete(unsigned* bar, unsigned x, unsigned& nloc, unsigned& nx) {
    const unsigned G = gridDim.x * gridDim.y * gridDim.z;
    unsigned sum, cnt, mine, sp = 0u;
    for (;;) {
        sum = 0u; cnt = 0u; mine = 0u;
#pragma unroll
        for (unsigned j = 0; j < 16; ++j) { const unsigned c = xb_ld(&bar[XB_XCNT(j)]); sum += c; cnt += (c > 0u) ? 1u : 0u; mine = (j == x) ? c : mine; }
        if (sum == G) break;
        __builtin_amdgcn_s_sleep(1);
        if ((++sp & 255u) == 0u) { if (xb_ld(&bar[XB_TMO])) break; if (sp > XB_SPIN_CAP) { atomicAdd(&bar[XB_TMO], 1u); break; } }
    }
    nloc = mine > 0u ? mine : 1u; nx = cnt > 0u ? cnt : 1u;
}

__device__ __forceinline__ void xcd_barrier(const XcdBarrier& b) {
    asm volatile("s_waitcnt vmcnt(0)" ::: "memory");
    __syncthreads();
    if (threadIdx.x == 0) {
        unsigned* bar = b.bar;
        __builtin_amdgcn_s_waitcnt(0);
        unsigned nloc = b.st[0], nx = b.st[1];
        if (nloc == 0u) { xcd_barrier_complete(bar, b.x, nloc, nx); b.st[0] = nloc; b.st[1] = nx; }
        const unsigned old = xb_add(&bar[XB_XSUB(b.x)], 1u);
        const unsigned gen = old / nloc;
        if (old + 1u == (gen + 1u) * nloc) {
            __builtin_amdgcn_fence(__ATOMIC_RELEASE, "agent");
            asm volatile("s_waitcnt vmcnt(0)" ::: "memory");
            const unsigned og = xb_add(&bar[XB_TOP], 1u);
            const unsigned tg = og / nx;
            if (og + 1u == (tg + 1u) * nx) xb_add(&bar[XB_TOPGEN], 1u);
            else XB_SPIN(xb_ld(&bar[XB_TOPGEN]) == tg, bar);
            __builtin_amdgcn_fence(__ATOMIC_ACQUIRE, "agent");
            xb_add(&bar[XB_XGEN(b.x)], 1u);
            asm volatile("s_waitcnt vmcnt(0)" ::: "memory");
        } else {
            XB_SPIN(xb_ld(&bar[XB_XGEN(b.x)]) == gen, bar);
            __builtin_amdgcn_fence(__ATOMIC_ACQUIRE, "agent");
            asm volatile("s_waitcnt vmcnt(0)" ::: "memory");
        }
    }
    __syncthreads();
}

#ifdef NT_P0
#define P0LD(p) __builtin_nontemporal_load(p)
#else
#define P0LD(p) (*(p))
#endif
__device__ __forceinline__ void tr_item(const float* W, const float* gain, int K, int N, bf16_t* WT, LAS float* scr, int item, int lane) {
    const int nblk = N / 32, kb = item / nblk, nb = item % nblk, k0 = 64 * kb, n0 = 32 * nb;
    float wv[32];
#pragma unroll
    for (int i = 0; i < 32; ++i) wv[i] = P0LD(&W[(size_t)(k0 + 2 * i + (lane >> 5)) * N + n0 + (lane & 31)]);
    if (gain) {
#pragma unroll
        for (int i = 0; i < 32; ++i) wv[i] *= gain[k0 + 2 * i + (lane >> 5)]; }
#pragma unroll
    for (int i = 0; i < 32; ++i) scr[(2 * i + (lane >> 5)) * 33 + (lane & 31)] = wv[i];
    LDS_WAIT(); asm volatile("" ::: "memory");
    const int c = lane & 7;
#pragma unroll
    for (int jj = 0; jj < 4; ++jj) { const int n = (lane >> 3) + 8 * jj; const LAS float* s = scr + (8 * c) * 33 + n;
        u32x4 o; o.x = pk2(s[0 * 33], s[1 * 33]); o.y = pk2(s[2 * 33], s[3 * 33]); o.z = pk2(s[4 * 33], s[5 * 33]); o.w = pk2(s[6 * 33], s[7 * 33]);
#ifdef NT2
        __builtin_nontemporal_store(o, (u32x4*)(WT + (size_t)(n0 + n) * K + k0 + 8 * c)); }
#else
        *(u32x4*)(WT + (size_t)(n0 + n) * K + k0 + 8 * c) = o; }
#endif
    LDS_WAIT(); asm volatile("" ::: "memory");
}

struct Args { const float* in[13]; float* out; unsigned char* ws; };

#define OPAQUE_IDS() int tid_ = threadIdx.x, bx_ = blockIdx.x; asm volatile("" : "+v"(tid_), "+s"(bx_)); const int tid = tid_, lane = tid & 63, wave = __builtin_amdgcn_readfirstlane(tid >> 6); \
    const int G = gridDim.x, vcu = (G % 8 == 0) ? (bx_ % 8) * (G / 8) + bx_ / 8 : bx_; (void)tid; (void)lane; (void)wave; (void)vcu
__device__ __forceinline__ void p0_prologue(const Args& a, LAS unsigned char* lds) {
    OPAQUE_IDS();
    unsigned char* ws = a.ws;
    LAS float* scr = (LAS float*)(lds + wave * 16384);
    const int gw = vcu * 8 + wave, NGW = G * 8;
    constexpr int I_QKV = 16 * 96, I_O = 16 * 32, I_IN = 16 * 128, I_OUT = 32 * 32, I_1 = 16 * 128, I_2 = 64 * 32;
    constexpr int NITEMS = 2 * I_QKV + 2 * I_O + 2 * I_IN + 2 * I_OUT + 4 * I_1 + 4 * I_2;
    for (int it = gw; it < NITEMS; it += NGW) {
        int r = it; const float* W; const float* gain = nullptr; int K, N; bf16_t* WT;
        if (r < 2 * I_QKV) { const int j = r / I_QKV; r -= j * I_QKV; W = a.in[3] + (size_t)j * D * 3 * D; gain = a.in[1] + (size_t)(2 * j) * D; K = D; N = 3 * D; WT = (bf16_t*)(ws + WS_WQKV) + (size_t)j * 3 * D * D; }
        else if ((r -= 2 * I_QKV) < 2 * I_O) { const int j = r / I_O; r -= j * I_O; W = a.in[4] + (size_t)j * D * D; K = D; N = D; WT = (bf16_t*)(ws + WS_WO) + (size_t)j * D * D; }
        else if ((r -= 2 * I_O) < 2 * I_IN) { const int j = r / I_IN; r -= j * I_IN; W = a.in[5] + (size_t)j * D * 2 * SF; gain = a.in[1] + (size_t)(2 * j + 1) * D; K = D; N = 2 * SF; WT = (bf16_t*)(ws + WS_WIN) + (size_t)j * 2 * SF * D; }
        else if ((r -= 2 * I_IN) < 2 * I_OUT) { const int j = r / I_OUT; r -= j * I_OUT; W = a.in[9] + (size_t)j * SF * D; K = SF; N = D; WT = (bf16_t*)(ws + WS_WOUT) + (size_t)j * D * SF; }
        else if ((r -= 2 * I_OUT) < 4 * I_1) { const int j = r / I_1; r -= j * I_1; W = a.in[10] + (size_t)j * D * FF; gain = a.in[2] + (size_t)j * D; K = D; N = FF; WT = (bf16_t*)(ws + WS_W1) + (size_t)j * FF * D; }
        else { r -= 4 * I_1; const int j = r / I_2; r -= j * I_2; W = a.in[11] + (size_t)j * FF * D; K = FF; N = D; WT = (bf16_t*)(ws + WS_W2) + (size_t)j * D * FF; }
        tr_item(W, gain, K, N, WT, scr, r, lane);
    }
    const float* x = a.in[0]; bf16_t* XB = (bf16_t*)(ws + WS_XB); bf16_t* XL = (bf16_t*)(ws + WS_XL); float* stat = (float*)(ws + WS_STAT);
    for (int m0 = gw; m0 < M; m0 += 4 * NGW) {
        f32x4 v[4][4];
#pragma unroll
        for (int q = 0; q < 4; ++q) { const int m = m0 + q * NGW; const f32x4* xr = (const f32x4*)(x + (size_t)(m < M ? m : m0) * D) + lane;
#pragma unroll
            for (int jj = 0; jj < 4; ++jj) v[q][jj] = P0LD(&xr[64 * jj]); }
#pragma unroll
        for (int q = 0; q < 4; ++q) { const int m = m0 + q * NGW; if (m >= M) break; float s = 0.f;
#pragma unroll
            for (int jj = 0; jj < 4; ++jj) s += (v[q][jj].x * v[q][jj].x + v[q][jj].y * v[q][jj].y) + (v[q][jj].z * v[q][jj].z + v[q][jj].w * v[q][jj].w);
            s = wave_sum(s); if (lane < 16) stat[(size_t)m * 16 + lane] = (lane == 0) ? s : 0.f;
            u32x2* o8 = (u32x2*)(XB + (size_t)m * D) + lane; u32x2* l8 = (u32x2*)(XL + (size_t)m * D) + lane;
#pragma unroll
            for (int jj = 0; jj < 4; ++jj) { u32x2 w, l; w.x = pk2(v[q][jj].x, v[q][jj].y); w.y = pk2(v[q][jj].z, v[q][jj].w);
                l.x = pk2(v[q][jj].x - __uint_as_float(w.x << 16), v[q][jj].y - __uint_as_float(w.x & 0xffff0000u));
                l.y = pk2(v[q][jj].z - __uint_as_float(w.y << 16), v[q][jj].w - __uint_as_float(w.y & 0xffff0000u));
#ifdef NT2
                __builtin_nontemporal_store(w, &o8[64 * jj]); __builtin_nontemporal_store(l, &l8[64 * jj]);
#else
                o8[64 * jj] = w; if (RES_LO) l8[64 * jj] = l;
#endif
            } }
    }
}

__device__ __forceinline__ void attn_phase(const bf16_t* __restrict__ Q, const bf16_t* __restrict__ Kb, const bf16_t* __restrict__ VT, bf16_t* __restrict__ O) {
    OPAQUE_IDS();
    const int r = lane & 31, h = lane >> 5;
    for (int u = vcu; u < BATCH * NH * (SEQ / 256); u += G) {
        const int qb = u & 7, bh = u >> 3, hh = bh & 15, b = bh >> 4;
        const int t0 = qb * 256 + wave * 32;
        const size_t rowb = (size_t)b * SEQ;
        const size_t tile0 = (size_t)((b * NH + hh) * (SEQ / 32)) << 11;
        bf16x8 qf[4];
        { const bf16_t* qp = Q + tile0 + ((size_t)(t0 >> 5) << 11) + lane * 8;
#pragma unroll
          for (int d0 = 0; d0 < 4; ++d0) qf[d0] = *(const bf16x8*)(qp + d0 * 512); }
        f32x16 o0, o1;
#pragma unroll
        for (int i = 0; i < 16; ++i) { o0[i] = 0.f; o1[i] = 0.f; }
        float carry = 1.f;
        const bf16_t* kbase = Kb + tile0 + lane * 8;
        const bf16_t* vbase = VT + tile0 + lane * 4;
        bf16x8 kf[4]; s16x4 va[2][2][2];
#define ATT_LOAD(KF, VA, s0_) do { const bf16_t* kp_ = kbase + ((size_t)((s0_) >> 5) << 11); const bf16_t* vp_ = vbase + ((size_t)((s0_) >> 5) << 11); \
        _Pragma("unroll") for (int d0 = 0; d0 < 4; ++d0) KF[d0] = *(const bf16x8*)(kp_ + d0 * 512); \
        _Pragma("unroll") for (int db = 0; db < 2; ++db) _Pragma("unroll") for (int s = 0; s < 2; ++s) { VA[db][s][0] = *(const s16x4*)(vp_ + ((db * 2 + s) * 2 + 0) * 256); VA[db][s][1] = *(const s16x4*)(vp_ + ((db * 2 + s) * 2 + 1) * 256); } } while (0)
        ATT_LOAD(kf, va, t0);
        bf16x8 kn[4]; s16x4 vn[2][2][2];
        { const int sn = t0 >= 32 ? t0 - 32 : 0; ATT_LOAD(kn, vn, sn); }
        for (int kt = t0 >> 5; kt >= 0; --kt) {
            const int s0 = kt * 32;
            bf16x8 k2[4]; s16x4 v2[2][2][2];
            { const int sn = kt > 1 ? s0 - 64 : 0; ATT_LOAD(k2, v2, sn); }
            f32x16 X;
#pragma unroll
            for (int i = 0; i < 16; ++i) X[i] = 0.f;
#pragma unroll
            for (int d0 = 0; d0 < 4; ++d0) X = MFMA32(kf[d0], qf[d0], X);
            const bool diag = (s0 == t0);
            float Ev[16], Dv[16], A[16];
#pragma unroll
            for (int i = 0; i < 16; ++i) { const float z = fminf(X[i], 31.f); float E = __builtin_amdgcn_exp2f(z);
                if (diag) E = (crow(i, h) < r) ? E : 0.f;
                Ev[i] = E; Dv[i] = 1.f + E; }
            float gp[4], og[4];
#pragma unroll
            for (int g = 0; g < 4; ++g) { gp[g] = __builtin_amdgcn_rcpf((Dv[4 * g] * Dv[4 * g + 1]) * (Dv[4 * g + 2] * Dv[4 * g + 3])); og[g] = __shfl_xor(gp[g], 32); }
            float sp = carry;
#pragma unroll
            for (int g = 3; g >= 0; --g) { const float gs = (h == 0) ? sp * og[g] : sp;
                const float gi = gs * gp[g], t1 = gi * Dv[4 * g], t2 = t1 * Dv[4 * g + 1], t3 = t2 * Dv[4 * g + 2];
                A[4 * g] = Ev[4 * g] * gi; A[4 * g + 1] = Ev[4 * g + 1] * t1; A[4 * g + 2] = Ev[4 * g + 2] * t2; A[4 * g + 3] = Ev[4 * g + 3] * t3;
                sp *= gp[g] * og[g]; }
            carry = sp;
            bf16x8 pf[2];
#pragma unroll
            for (int s = 0; s < 2; ++s) { u32x4 p; p.x = pk2(A[8 * s], A[8 * s + 1]); p.y = pk2(A[8 * s + 2], A[8 * s + 3]); p.z = pk2(A[8 * s + 4], A[8 * s + 5]); p.w = pk2(A[8 * s + 6], A[8 * s + 7]); pf[s] = __builtin_bit_cast(bf16x8, p); }
#pragma unroll
            for (int s = 0; s < 2; ++s) {
                const bf16x8 v0 = __builtin_shufflevector(va[0][s][0], va[0][s][1], 0, 1, 2, 3, 4, 5, 6, 7);
                const bf16x8 v1 = __builtin_shufflevector(va[1][s][0], va[1][s][1], 0, 1, 2, 3, 4, 5, 6, 7);
                o0 = MFMA32(pf[s], v0, o0); o1 = MFMA32(pf[s], v1, o1); }
            if (__builtin_amdgcn_ballot_w64(carry >= 1.17549435e-38f) == 0ull) break;
#pragma unroll
            for (int d0 = 0; d0 < 4; ++d0) { kf[d0] = kn[d0]; kn[d0] = k2[d0]; }
#pragma unroll
            for (int db = 0; db < 2; ++db)
#pragma unroll
                for (int s = 0; s < 2; ++s) { va[db][s][0] = vn[db][s][0]; va[db][s][1] = vn[db][s][1]; vn[db][s][0] = v2[db][s][0]; vn[db][s][1] = v2[db][s][1]; }
        }
#undef ATT_LOAD
        bf16_t* op = O + (rowb + t0) * D + hh * HD + r;
#pragma unroll
        for (int i = 0; i < 16; ++i) { const size_t ro = (size_t)crow(i, h) * D;
#ifdef NT2
            __builtin_nontemporal_store(f2bf(o0[i]), op + ro); __builtin_nontemporal_store(f2bf(o1[i]), op + ro + 32);
#else
            op[ro] = f2bf(o0[i]); op[ro + 32] = f2bf(o1[i]);
#endif
        }
    }
}

#define MFMA16(a, b, c) __builtin_amdgcn_mfma_f32_16x16x32_bf16((a), (b), (c), 0, 0, 0)
template <bool REAL> __device__ __forceinline__ void sgu_mix_phase(LAS unsigned char* lds, const float* wsj, const float* bsj, const float* gainj, const float* vstat, const bf16_t* VT2, bf16_t* UY) {
    OPAQUE_IDS();
    const int q = lane >> 4, tl = lane & 15;
    constexpr int ROWB = 272, NU = BATCH * (SEQ / SC) * SG;
    LAS float* rsT = (LAS float*)(lds + 128 * ROWB);
    const int g = vcu & 7;
    const int c0 = g * SGW + wave * 32;
    const int c4 = (tid & 31) * 4;
    f32x4 wsr[8];
    { const float* wsg = wsj + (size_t)g * SC * SC;
#pragma unroll
      for (int it = 0; it < 8; ++it) wsr[it] = *(const f32x4*)(wsg + ((tid >> 5) + 16 * it) * SC + c4); }
    const f32x4 g0 = *(const f32x4*)(gainj + c0 + 8 * q), g1 = *(const f32x4*)(gainj + c0 + 8 * q + 4);
    bf16x8 va[4][2]; u32x4 uu[8]; f32x4 vs4;
#ifdef NT2
#define MIXLD(T, p) __builtin_nontemporal_load((const T*)(p))
#else
#define MIXLD(T, p) (*(const T*)(p))
#endif
#define MIX_LOAD(VA, UU, VS, u_) do { const size_t tok0_ = (size_t)((u_) >> 3) * SC; \
        const bf16_t* vp_ = VT2 + (size_t)(c0 + 8 * (tl >> 2) + (tl & 3)) * PV + tok0_ + q * 8; \
        _Pragma("unroll") for (int ks = 0; ks < 4; ++ks) { VA[ks][0] = MIXLD(bf16x8, vp_ + ks * 32); VA[ks][1] = MIXLD(bf16x8, vp_ + 4 * PV + ks * 32); } \
        const bf16_t* up_ = UY + (tok0_ + tl) * SF + c0 + 8 * q; \
        _Pragma("unroll") for (int tb = 0; tb < 8; ++tb) UU[tb] = MIXLD(u32x4, up_ + (size_t)tb * 16 * SF); \
        VS = *(const f32x4*)(vstat + (tok0_ + (tid >> 2)) * 16 + (tid & 3) * 4); } while (0)
    if ((G & 7) != 0) return;
    if (vcu < NU) MIX_LOAD(va, uu, vs4, vcu);
    for (int u = vcu; u < NU; u += G) {
        const size_t tok0 = (size_t)(u >> 3) * SC;
        { float sq = (vs4[0] + vs4[1]) + (vs4[2] + vs4[3]); sq += __shfl_xor(sq, 1); sq += __shfl_xor(sq, 2);
          if ((tid & 3) == 0) rsT[tid >> 2] = __builtin_amdgcn_rsqf(sq * (1.f / SF) + EPS); }
        bf16x8 vn[4][2]; u32x4 un[8]; f32x4 vsn;
        { const int un_ = (u + G < NU) ? u + G : u; MIX_LOAD(vn, un, vsn, un_); }
        __syncthreads();
        { const f32x4 rs = *(const LAS f32x4*)(rsT + c4);
#pragma unroll
          for (int it = 0; it < 8; ++it) { const int t = (tid >> 5) + 16 * it; const f32x4 w = wsr[it];
              const float a0 = (c4 + 0 <= t) ? w[0] * rs[0] : 0.f, a1 = (c4 + 1 <= t) ? w[1] * rs[1] : 0.f, a2 = (c4 + 2 <= t) ? w[2] * rs[2] : 0.f, a3 = (c4 + 3 <= t) ? w[3] * rs[3] : 0.f;
              u32x2 p; p.x = pk2(a0, a1); p.y = pk2(a2, a3); *(LAS u32x2*)(lds + t * ROWB + c4 * 2) = p; } }
        __syncthreads();
        bf16_t* up = UY + (tok0 + tl) * SF + c0 + 8 * q;
#pragma unroll
        for (int tb = 0; tb < 8; ++tb) {
            f32x4 a0 = {0.f, 0.f, 0.f, 0.f}, a1 = {0.f, 0.f, 0.f, 0.f};
#pragma unroll
            for (int ks = 0; ks <= (tb >> 1); ++ks) { const bf16x8 bfr = *(const LAS bf16x8*)(lds + (tb * 16 + tl) * ROWB + (ks * 32 + q * 8) * 2);
                a0 = MFMA16(va[ks][0], bfr, a0); a1 = MFMA16(va[ks][1], bfr, a1); }
            const float bsv = bsj[g * SC + tb * 16 + tl];
            const u32x4 w = uu[tb]; u32x4 o;
            o.x = pk2(__uint_as_float(w.x << 16) * (g0[0] * a0[0] + bsv), __uint_as_float(w.x & 0xffff0000u) * (g0[1] * a0[1] + bsv));
            o.y = pk2(__uint_as_float(w.y << 16) * (g0[2] * a0[2] + bsv), __uint_as_float(w.y & 0xffff0000u) * (g0[3] * a0[3] + bsv));
            o.z = pk2(__uint_as_float(w.z << 16) * (g1[0] * a1[0] + bsv), __uint_as_float(w.z & 0xffff0000u) * (g1[1] * a1[1] + bsv));
            o.w = pk2(__uint_as_float(w.w << 16) * (g1[2] * a1[2] + bsv), __uint_as_float(w.w & 0xffff0000u) * (g1[3] * a1[3] + bsv));
            if (REAL || o.x == 0x12345678u) {
#if 1
                __builtin_nontemporal_store(o, (u32x4*)(up + (size_t)tb * 16 * SF));
#else
                *(u32x4*)(up + (size_t)tb * 16 * SF) = o;
#endif
            }
        }
#pragma unroll
        for (int ks = 0; ks < 4; ++ks) { va[ks][0] = vn[ks][0]; va[ks][1] = vn[ks][1]; }
#pragma unroll
        for (int tb = 0; tb < 8; ++tb) uu[tb] = un[tb];
        vs4 = vsn;
    }
#undef MIX_LOAD
}

#ifdef TSEL
#define STAMP(id) do { const unsigned long long tn_ = __builtin_amdgcn_s_memrealtime(); if ((((unsigned)TSEL) >> (id)) & 1u) tsum += tn_ - tprev; tprev = tn_; } while (0)
#else
#define STAMP(id) do { } while (0)
#endif
struct FastSync { XcdBarrier b; __device__ __forceinline__ void sync() const { xcd_barrier(b); } };
template <int PAR> __device__ __forceinline__ void layer_fwd(const Args& a, const FastSync& grid, LAS unsigned char* lds, const int i, unsigned long long& tprev, unsigned long long& tsum) {
    const int G = gridDim.x, bx = blockIdx.x;
    unsigned char* ws = a.ws;
    float* stat = (float*)(ws + WS_STAT);
    bf16_t* XB = (bf16_t*)(ws + WS_XB); bf16_t* XL = (bf16_t*)(ws + WS_XL); (void)XL;
    bf16_t* BIG = (bf16_t*)(ws + WS_BIG);
    bf16_t* Qb = BIG; bf16_t* Kb = BIG + (size_t)M * D; bf16_t* Ob = BIG + 2 * (size_t)M * D; bf16_t* VT = BIG + 3 * (size_t)M * D;
    bf16_t* UY = BIG; bf16_t* VT2 = BIG + (size_t)M * SF; bf16_t* Hb = BIG;
    (void)Qb; (void)Kb; (void)VT; (void)Ob; (void)UY; (void)VT2; (void)Hb;
        const int j = i >> 1;
        const float* stat_in = stat + (size_t)(2 * i) * STAT_ELEMS; float* stat_mid = stat + (size_t)(2 * i + 1) * STAT_ELEMS; float* stat_out = stat + (size_t)(2 * i + 2) * STAT_ELEMS;
        if constexpr (PAR == 0) {
            const bf16_t* Wqkv = (const bf16_t*)(ws + WS_WQKV) + (size_t)j * 3 * D * D;
            { pg8::Gemm g{XB, Wqkv, M, 2 * D, D}; pg8::StaticOrder S; S.init(M, 2 * D, G, bx);
              pg8::EpiRow<0, true> E{Qb, D, stat_in, 1.f / D, D, (size_t)M * D, QSCALE};
              pg8::gemm_phase<pg8::EpiRow<0, true>, pg8::StaticOrder, PG_ALIGN, PG_SP2>(lds, g, S, E);

            }
            { pg8::Gemm g{Wqkv + (size_t)2 * D * D, XB, D, M, D}; pg8::StaticOrder S; S.init(D, M, G, bx);
              pg8::EpiCol<0, false, true> E{VT, PV, stat_in, 1.f / D, nullptr};
              pg8::gemm_phase<pg8::EpiCol<0, false, true>, pg8::StaticOrder, PG_ALIGN, PG_SP2>(lds, g, S, E);

            }
            grid.sync(); STAMP(1 + 5 * i + 0);
#ifndef NO_ATT
            attn_phase(Qb, Kb, VT, Ob);
#ifdef PROBE_ATT2
            attn_phase(Qb, Kb, VT, Ob);
#endif
#endif
            grid.sync(); STAMP(1 + 5 * i + 1);
            { pg8::Gemm g{Ob, (const bf16_t*)(ws + WS_WO) + (size_t)j * D * D, M, D, D}; pg8::StaticOrder S; S.init(M, D, G, bx);
              pg8::EpiRes E{XB, XL, stat_mid, D};
              pg8::gemm_phase<pg8::EpiRes, pg8::StaticOrder, PG_ALIGN, PG_SP2>(lds, g, S, E);
#ifdef PROBE_WO
              if (i == 0) pg8::gemm_phase<pg8::EpiRes, pg8::StaticOrder, PG_ALIGN, PG_SP2>(lds, g, S, E);
#endif
            }
            grid.sync(); STAMP(1 + 5 * i + 2);
        } else {
            const bf16_t* Win = (const bf16_t*)(ws + WS_WIN) + (size_t)j * 2 * SF * D;
            float* vstat = stat + (size_t)(9 + j) * STAT_ELEMS;
            { pg8::Gemm g{XB, Win, M, SF, D}; pg8::StaticOrder S; S.init(M, SF, G, bx);
              pg8::EpiRow<2> E{UY, SF, stat_in, 1.f / D, 0, 0, 1.f};
              pg8::gemm_phase<pg8::EpiRow<2>, pg8::StaticOrder, PG_ALIGN, PG_SP2>(lds, g, S, E);
#ifdef PROBE_GC
              pg8::gemm_phase<pg8::EpiRow<2>, pg8::StaticOrder, PG_ALIGN, PG_SP2>(lds, g, S, E);
#endif
            }
            { pg8::Gemm g{Win + (size_t)SF * D, XB, SF, M, D}; pg8::StaticOrder S; S.init(SF, M, G, bx);
              pg8::EpiCol<2, true> E{VT2, PV, stat_in, 1.f / D, vstat};
              pg8::gemm_phase<pg8::EpiCol<2, true>, pg8::StaticOrder, PG_ALIGN, PG_SP2>(lds, g, S, E);
#ifdef PROBE_GD
              pg8::gemm_phase<pg8::EpiCol<2, true>, pg8::StaticOrder, PG_ALIGN, PG_SP2>(lds, g, S, E);
#endif
            }
            grid.sync(); STAMP(1 + 5 * i + 0);
#ifndef NO_MIX
#ifdef PROBE_MIX2
            sgu_mix_phase<false>(lds, a.in[7] + (size_t)j * SG * SC * SC, a.in[8] + (size_t)j * SG * SC, a.in[6] + (size_t)j * SF, vstat, VT2, UY);
#endif
            sgu_mix_phase<true>(lds, a.in[7] + (size_t)j * SG * SC * SC, a.in[8] + (size_t)j * SG * SC, a.in[6] + (size_t)j * SF, vstat, VT2, UY);
#endif
            grid.sync(); STAMP(1 + 5 * i + 1);
            { pg8::Gemm g{UY, (const bf16_t*)(ws + WS_WOUT) + (size_t)j * D * SF, M, D, SF}; pg8::StaticOrder S; S.init(M, D, G, bx);
              pg8::EpiRes E{XB, XL, stat_mid, D};
              pg8::gemm_phase<pg8::EpiRes, pg8::StaticOrder, PG_ALIGN, PG_SP2>(lds, g, S, E); }
            grid.sync(); STAMP(1 + 5 * i + 2);
        }
#ifdef VAR_W1
        if (i == 0) { grid.sync(); tprev = __builtin_amdgcn_s_memrealtime();
#ifdef VAR_STAG
          if ((bx >> 3) & 3) { const unsigned long long t0_ = __builtin_amdgcn_s_memrealtime(); while (__builtin_amdgcn_s_memrealtime() - t0_ < (unsigned long long)(VAR_STAG * ((bx >> 3) & 3))) __builtin_amdgcn_s_sleep(8); }
#endif
          { pg8::Gemm g{XB, (const bf16_t*)(ws + WS_W1) + (size_t)i * FF * D, M, FF, D}; pg8::StaticOrder S; S.init(M, FF, G, bx);
            pg8::EpiVar<VAR_W1> E{Hb, FF, stat_mid, 1.f / D};
            pg8::gemm_phase<pg8::EpiVar<VAR_W1>, pg8::StaticOrder, PG_ALIGN, PG_SP2>(lds, g, S, E); }
          grid.sync(); STAMP(30); }
#endif
#ifdef STAGGER_W1
        if (bx & 8) { const unsigned long long t0_ = __builtin_amdgcn_s_memrealtime(); while (__builtin_amdgcn_s_memrealtime() - t0_ < (unsigned long long)STAGGER_W1) __builtin_amdgcn_s_sleep(8); }
#endif
        { pg8::Gemm g{XB, (const bf16_t*)(ws + WS_W1) + (size_t)i * FF * D, M, FF, D}; pg8::StaticOrder S; S.init(M, FF, G, bx);
          pg8::EpiRow<1> E{Hb, FF, stat_mid, 1.f / D, 0, 0, 1.f};
          pg8::gemm_phase<pg8::EpiRow<1>, pg8::StaticOrder, PG_ALIGN, PG_SP2>(lds, g, S, E);
#ifdef PROBE_W12
          pg8::gemm_phase<pg8::EpiRow<1>, pg8::StaticOrder, PG_ALIGN, PG_SP2>(lds, g, S, E);
#endif
        }
        grid.sync(); STAMP(1 + 5 * i + 3);
#ifdef PROBE_W2
        { pg8::Gemm g{Hb, (const bf16_t*)(ws + WS_W2) + (size_t)i * D * FF, M, D, FF}; pg8::StaticOrder S; S.init(M, D, G, bx);
          pg8::EpiRow<0> E{XB, D, stat_mid, 1.f / D, 0, 0, 1.f};
          pg8::gemm_phase<pg8::EpiRow<0>, pg8::StaticOrder, PG_ALIGN, PG_SP2>(lds, g, S, E); }
#endif
        { pg8::Gemm g{Hb, (const bf16_t*)(ws + WS_W2) + (size_t)i * D * FF, M, D, FF}; pg8::StaticOrder S; S.init(M, D, G, bx);
          pg8::EpiRes E{XB, XL, stat_out, D};
          pg8::gemm_phase<pg8::EpiRes, pg8::StaticOrder, PG_ALIGN, PG_SP2>(lds, g, S, E); }
        grid.sync(); STAMP(1 + 5 * i + 4);

}

__global__ void __launch_bounds__(512, 2) fwd_megakernel(Args a) {
    extern __shared__ __attribute__((aligned(16))) unsigned char lds_raw[];
    cg::grid_group grid = cg::this_grid();
    LAS unsigned char* lds = (LAS unsigned char*)lds_raw;
    unsigned* barw = (unsigned*)(a.ws + WS_END + 4096);
    if (blockIdx.x == 0) for (int w = threadIdx.x; w < XCD_BAR_WORDS; w += 512) barw[w] = 0u;
    volatile LAS unsigned* bst = (volatile LAS unsigned*)(lds + 131072 + 64);
    if (threadIdx.x == 0) { bst[0] = 0u; bst[1] = 0u; }
    __threadfence(); __syncthreads();
    const int G = gridDim.x, bx = blockIdx.x;
    unsigned char* ws = a.ws;
    float* stat = (float*)(ws + WS_STAT);
    bf16_t* XB = (bf16_t*)(ws + WS_XB); bf16_t* XL = (bf16_t*)(ws + WS_XL); (void)XL;
    bf16_t* BIG = (bf16_t*)(ws + WS_BIG);
    bf16_t* Qb = BIG; bf16_t* Kb = BIG + (size_t)M * D; bf16_t* Ob = BIG + 2 * (size_t)M * D; bf16_t* VT = BIG + 3 * (size_t)M * D;
    bf16_t* UY = BIG; bf16_t* VT2 = BIG + (size_t)M * SF; bf16_t* Hb = BIG;

#ifdef TSEL
    const unsigned long long t_begin = __builtin_amdgcn_s_memrealtime();
#endif
#ifndef NO_P0
    p0_prologue(a, lds);
#ifdef PROBE_P02
    __syncthreads(); p0_prologue(a, lds);
#endif
#endif
    grid.sync();
    FastSync fsync; fsync.b = xcd_barrier_post(barw, bst);
    unsigned long long tprev = 0ull, tsum = 0ull;
#ifdef TSEL
    tprev = t_begin; STAMP(0);
#endif

#ifdef LAYER_LOOP
#pragma unroll 1
    for (int jj = 0; jj < DEPTH; jj += 2) { layer_fwd<0>(a, fsync, lds, jj, tprev, tsum); layer_fwd<1>(a, fsync, lds, jj + 1, tprev, tsum); }
#else
    layer_fwd<0>(a, fsync, lds, 0, tprev, tsum); layer_fwd<1>(a, fsync, lds, 1, tprev, tsum); layer_fwd<0>(a, fsync, lds, 2, tprev, tsum); layer_fwd<1>(a, fsync, lds, 3, tprev, tsum);
#endif
#ifdef TSEL
    float tdelta = 0.f;
    { unsigned long long* tw = (unsigned long long*)(ws + WS_END);
      if (blockIdx.x == 0 && threadIdx.x == 0) { *tw = tsum; __threadfence(); }
      grid.sync();
      tdelta = (float)(*(volatile unsigned long long*)tw) * 1e-7f; tprev = __builtin_amdgcn_s_memrealtime(); }
#ifdef TCAL
    tdelta = TCAL;
#endif
#endif
#ifdef NT2
#define FINLD(p) __builtin_nontemporal_load(p)
#else
#define FINLD(p) (*(p))
#endif
    { OPAQUE_IDS(); const float* st = stat + (size_t)8 * STAT_ELEMS; const f32x4* gn = (const f32x4*)a.in[12] + lane; const int gw = vcu * 8 + wave, NGW = G * 8;
      const bf16_t* XBf = (const bf16_t*)(ws + WS_XB); const bf16_t* XLf = (const bf16_t*)(ws + WS_XL);
      f32x4 gv[4];
#pragma unroll
      for (int jj = 0; jj < 4; ++jj) gv[jj] = gn[64 * jj];
      for (int m0 = gw; m0 < M; m0 += 4 * NGW) {
          u32x2 hw[4][4], lw[4][4]; float sp[4];
#pragma unroll
          for (int q = 0; q < 4; ++q) { const int m = (m0 + q * NGW < M) ? m0 + q * NGW : m0; const u32x2* h8 = (const u32x2*)(XBf + (size_t)m * D) + lane; const u32x2* l8 = (const u32x2*)(XLf + (size_t)m * D) + lane;
              sp[q] = lane < 16 ? st[(size_t)m * 16 + lane] : 0.f;
#pragma unroll
              for (int jj = 0; jj < 4; ++jj) { hw[q][jj] = FINLD(&h8[64 * jj]); lw[q][jj] = RES_LO ? FINLD(&l8[64 * jj]) : (u32x2){0u, 0u}; } }
#pragma unroll
          for (int q = 0; q < 4; ++q) { const int m = m0 + q * NGW; if (m >= M) break; f32x4* xr = (f32x4*)(a.out + (size_t)m * D) + lane;
              const float rs = __builtin_amdgcn_rsqf(wave_sum(sp[q]) * (1.f / D) + EPS);
#pragma unroll
              for (int jj = 0; jj < 4; ++jj) { const u32x2 h2 = hw[q][jj], l2 = lw[q][jj]; f32x4 v;
                  v.x = __uint_as_float(h2.x << 16) + __uint_as_float(l2.x << 16); v.y = __uint_as_float(h2.x & 0xffff0000u) + __uint_as_float(l2.x & 0xffff0000u);
                  v.z = __uint_as_float(h2.y << 16) + __uint_as_float(l2.y << 16); v.w = __uint_as_float(h2.y & 0xffff0000u) + __uint_as_float(l2.y & 0xffff0000u);
                  v = v * rs * gv[jj];
#if defined(TSEL) && !defined(TFINAL)
                  if (jj == 0 && lane < 4) v = v + tdelta;
#endif
                  __builtin_nontemporal_store(v, &xr[64 * jj]); } } }
      }
#ifdef PROBE_REP
    fsync.sync(); p0_prologue(a, lds); fsync.sync();
    layer_fwd<0>(a, fsync, lds, 0, tprev, tsum); layer_fwd<1>(a, fsync, lds, 1, tprev, tsum); layer_fwd<0>(a, fsync, lds, 2, tprev, tsum); layer_fwd<1>(a, fsync, lds, 3, tprev, tsum);
    { OPAQUE_IDS(); const float* st = stat + (size_t)8 * STAT_ELEMS; const f32x4* gn = (const f32x4*)a.in[12] + lane; const int gw = vcu * 8 + wave, NGW = G * 8;
      const bf16_t* XBf = (const bf16_t*)(ws + WS_XB); const bf16_t* XLf = (const bf16_t*)(ws + WS_XL);
      f32x4 gv[4];
#pragma unroll
      for (int jj = 0; jj < 4; ++jj) gv[jj] = gn[64 * jj];
      for (int m = gw; m < M; m += NGW) { f32x4* xr = (f32x4*)(a.out + (size_t)m * D) + lane; const u32x2* h8 = (const u32x2*)(XBf + (size_t)m * D) + lane; const u32x2* l8 = (const u32x2*)(XLf + (size_t)m * D) + lane;
          const float rs = __builtin_amdgcn_rsqf(wave_sum(lane < 16 ? st[(size_t)m * 16 + lane] : 0.f) * (1.f / D) + EPS);
#pragma unroll
          for (int jj = 0; jj < 4; ++jj) { const u32x2 hw = FINLD(&h8[64 * jj]), lw = RES_LO ? FINLD(&l8[64 * jj]) : (u32x2){0u, 0u}; f32x4 v;
              v.x = __uint_as_float(hw.x << 16) + __uint_as_float(lw.x << 16); v.y = __uint_as_float(hw.x & 0xffff0000u) + __uint_as_float(lw.x & 0xffff0000u);
              v.z = __uint_as_float(hw.y << 16) + __uint_as_float(lw.y << 16); v.w = __uint_as_float(hw.y & 0xffff0000u) + __uint_as_float(lw.y & 0xffff0000u);
              v = v * rs * gv[jj];
#if defined(TSEL) && !defined(TFINAL)
              if (jj == 0 && lane < 4) v = v + tdelta;
#endif
#if 1
              __builtin_nontemporal_store(v, &xr[64 * jj]);
#else
              xr[64 * jj] = v;
#endif
          } } }
#endif
#ifdef TFINAL
    { unsigned long long* tw = (unsigned long long*)(ws + WS_END) + 8;
      grid.sync();
      const unsigned long long tn = __builtin_amdgcn_s_memrealtime();
      if (blockIdx.x == 0 && threadIdx.x == 0) { *tw = tn - tprev; __threadfence(); }
      grid.sync();
      const float td = (float)(*(volatile unsigned long long*)tw) * 1e-7f;
      OPAQUE_IDS(); const int gw = vcu * 8 + wave, NGW = G * 8;
      for (int m = gw; m < M; m += NGW) { if (lane < 4) { f32x4* xr = (f32x4*)(a.out + (size_t)m * D) + lane; xr[0] = xr[0] + td; } } }
#endif
}

extern "C" void kernel_launch(void* const* d_in, const int* in_sizes, int n_in, void* d_out, int out_size, void* d_ws, size_t ws_size, hipStream_t stream) {
    static int grid = 0;
    if (grid == 0) {
        if (n_in != 13 || in_sizes[0] != M * D || out_size != M * D || ws_size < WS_END) { fprintf(stderr, "kernel_launch: unexpected shapes (n_in %d, in0 %d, out %d, ws %zu)\n", n_in, n_in > 0 ? in_sizes[0] : -1, out_size, ws_size); grid = -1; return; }
        int dev = 0, cus = 0, per_cu = 0;
        if (hipGetDevice(&dev) != hipSuccess || hipDeviceGetAttribute(&cus, hipDeviceAttributeMultiprocessorCount, dev) != hipSuccess) { grid = -1; return; }
        if (hipFuncSetAttribute((const void*)fwd_megakernel, hipFuncAttributeMaxDynamicSharedMemorySize, LDS_BYTES) != hipSuccess) { fprintf(stderr, "kernel_launch: hipFuncSetAttribute failed\n"); grid = -1; return; }
        if (hipOccupancyMaxActiveBlocksPerMultiprocessor(&per_cu, (const void*)fwd_megakernel, 512, LDS_BYTES) != hipSuccess || per_cu < 1) { fprintf(stderr, "kernel_launch: occupancy query says %d\n", per_cu); per_cu = 1; }
        (void)hipGetLastError();
        grid = cus;
    }
    if (grid < 0) return;
    Args a{};
    for (int i = 0; i < 13; ++i) a.in[i] = (const float*)d_in[i];
    a.out = (float*)d_out; a.ws = (unsigned char*)d_ws;
    void* args[] = {&a};
    hipError_t e = hipLaunchCooperativeKernel((const void*)fwd_megakernel, dim3(grid), dim3(512), args, LDS_BYTES, stream);
    if (e != hipSuccess) fprintf(stderr, "kernel_launch: cooperative launch failed: %s (grid %d)\n", hipGetErrorString(e), grid);
}
```

```cpp
#define H_REGULAR 1
#include <hip/hip_runtime.h>
#include <hip/hip_cooperative_groups.h>
#include <cstdio>
#include <cstdint>
namespace cg = cooperative_groups;
#ifndef PG_WGM
#define PG_WGM 8
#endif
namespace pg8 {
#define PG8_LAS __attribute__((address_space(3)))
typedef unsigned short bf16_t;
typedef short bf16x8 __attribute__((ext_vector_type(8)));
typedef float f32x4 __attribute__((ext_vector_type(4)));
typedef unsigned u32x4 __attribute__((ext_vector_type(4)));
constexpr int BM = 256, BK = 64, HALF = 128, HTB = HALF * BK * 2  , STAGE_BYTES = 8 * HTB, NXCD = 8, WGM = PG_WGM;

__host__ __device__ __forceinline__ int lds_byte(int r, int c) { const int st = (r >> 4) * 2 + (c >> 5), rr = r & 15, cc = c & 31, ob = rr * 64 + cc * 2; return st * 1024 + (ob ^ (((ob >> 9) & 1) << 5)); }
__host__ __device__ __forceinline__ void stage_rc(int b, int& R, int& C) { const int st = b / 1024, sb = b % 1024, swz = sb ^ (((sb >> 9) & 1) << 5); R = (st >> 1) * 16 + swz / 64; C = (st & 1) * 32 + (swz % 64) / 2; }
__host__ __device__ __forceinline__ int perm32(int rho) { const int n = rho >> 4, i = rho & 15; return 8 * (i >> 2) + 4 * n + (i & 3); }

struct Unit { int pm, pn; };
struct Gemm { const bf16_t* A; const bf16_t* Bt; int M, N, K; };

struct StaticOrder {
    int nM, nN, nwg, G, c;
    __host__ __device__ void init(int M, int N, int G_, int c_) { nM = M / BM; nN = N / BM; nwg = nM * nN; G = G_; c = c_; }
    __host__ __device__ bool next(int i, Unit& u) const {
        const long L = (long)i * G + c; if (L >= nwg) return false;
        int wgid = (int)L; { const int q = nwg / NXCD, r = nwg % NXCD, xcd = wgid % NXCD, off = wgid / NXCD; wgid = (xcd < r ? xcd * (q + 1) : r * (q + 1) + (xcd - r) * q) + off; }
        const int nig = WGM * nN, gid = wgid / nig, fm = gid * WGM, gsz = (nM - fm) < WGM ? (nM - fm) : WGM;
        u.pm = fm + ((wgid % nig) % gsz); u.pn = (wgid % nig) / gsz; return true;
    }
    __device__ __forceinline__ void a_ready(const Unit&) const {}
    __device__ __forceinline__ void done(const Unit&) const {}
};

typedef float f32x2_t __attribute__((ext_vector_type(2))); typedef __bf16 bf16x2_t __attribute__((ext_vector_type(2))); typedef unsigned u32x2 __attribute__((ext_vector_type(2)));
__device__ __forceinline__ unsigned pk2(float lo, float hi) { f32x2_t v = {lo, hi}; bf16x2_t b = __builtin_convertvector(v, bf16x2_t); return __builtin_bit_cast(unsigned, b); }
constexpr float NORM_EPS = 1e-6f;
#ifndef RELAX_DEFAULT
#define RELAX_DEFAULT false
#endif
#if 1
#define ST16(p, v) __builtin_nontemporal_store((v), (u32x4*)(p))
#define ST8(p, v) __builtin_nontemporal_store((v), (u32x2*)(p))
#else
#define ST16(p, v) (*(u32x4*)(p) = (v))
#define ST8(p, v) (*(u32x2*)(p) = (v))
#endif
#if 1
#define ST16L(p, v) __builtin_nontemporal_store((v), (u32x4*)(p))
#else
#define ST16L(p, v) ST16R(p, v)
#endif
#ifdef NT_RESLD
#define LD16R(p) __builtin_nontemporal_load((const u32x4*)(p))
#else
#define LD16R(p) (*(const u32x4*)(p))
#endif
#ifdef NT_RES
#define ST16R(p, v) __builtin_nontemporal_store((v), (u32x4*)(p))
#else
#define ST16R(p, v) (*(u32x4*)(p) = (v))
#endif
#ifndef H_REGULAR
#define H_REGULAR 0
#endif
template <int ACT> __device__ __forceinline__ float act_fn(float x) {
    if (ACT == 1) { const float v = fmaxf(x, 0.f); return v * v; }
    if (ACT == 2) { const float e = __builtin_amdgcn_exp2f(-2.302208198f * x * (1.f + 0.044715f * x * x)); return x * __builtin_amdgcn_rcpf(1.f + e); }
    return x;
}
template <int ACT, bool TILED = false> struct EpiRow {
    static constexpr bool PERM = true, AFTER_DRAIN = false, RELAX_OK = RELAX_DEFAULT;
    bf16_t* O; int ldc; const float* stat; float inv_n; int split_cols; size_t split_stride; float scale0;
    template <class Sched> __device__ __forceinline__ void prepare(PG8_LAS float* tab, const Sched& S, int tid) const {
        Unit u;
#pragma unroll 4
        for (int ui = 0; S.next(ui, u); ++ui) { const f32x4* sp = (const f32x4*)(stat + (size_t)(u.pm * BM + (tid >> 1)) * 16 + (tid & 1) * 8); const f32x4 q = sp[0] + sp[1];
            float s = (q[0] + q[1]) + (q[2] + q[3]); s += __shfl_xor(s, 1); if (!(tid & 1)) tab[ui * 256 + (tid >> 1)] = __builtin_amdgcn_rsqf(s * inv_n + NORM_EPS); }
    }
    __device__ __forceinline__ void operator()(const f32x4 (&acc)[2][2][4][2], const Unit& u, int wr, int wc, int fr, int fq, int ui, const PG8_LAS float* tab) const {
        const int row0 = u.pm * BM + wr * 64 + fr; int colt = u.pn * BM; bf16_t* base = O; float sc = 1.f;
        if (split_cols) { const int t = colt / split_cols; base += (size_t)t * split_stride; colt -= t * split_cols; if (t == 0) sc = scale0; }
        const int col0 = colt + wc * 32 + 8 * fq;
#pragma unroll
        for (int ai = 0; ai < 2; ++ai)
#pragma unroll
            for (int m = 0; m < 4; ++m) { const int row = row0 + ai * HALF + m * 16; const float rs = tab[ui * 256 + ai * HALF + wr * 64 + m * 16 + fr];
                bf16_t* rowp = base + (size_t)row * ldc + col0;
#pragma unroll
                for (int bj = 0; bj < 2; ++bj) { f32x4 v0 = acc[ai][bj][m][0] * rs, v1 = acc[ai][bj][m][1] * rs;
#pragma unroll
                    for (int e = 0; e < 4; ++e) { v0[e] = act_fn<ACT>(v0[e]) * sc; v1[e] = act_fn<ACT>(v1[e]) * sc; }
                    u32x4 w; w.x = pk2(v0[0], v0[1]); w.y = pk2(v0[2], v0[3]); w.z = pk2(v1[0], v1[1]); w.w = pk2(v1[2], v1[3]);
                    if (TILED) { const int c = col0 + bj * HALF, hd = c >> 6, d = c & 63, b = row >> 11, sq = row & 2047, kt = sq >> 5, r = sq & 31;
                        ST16(base + ((size_t)(((b * 16 + hd) * 64 + kt)) << 11) + (d >> 4) * 512 + (((d >> 3) & 1) * 32 + r) * 8, w); }
                    else if (ACT == 1 && H_REGULAR) *(u32x4*)(rowp + bj * HALF) = w;
                    else ST16(rowp + bj * HALF, w); } }
    }
};
template <int V> struct EpiVar {
    static constexpr bool PERM = true, AFTER_DRAIN = false, RELAX_OK = false;
    bf16_t* O; int ldc; const float* stat; float inv_n;
    template <class Sched> __device__ __forceinline__ void prepare(PG8_LAS float*, const Sched&, int) const {}
    __device__ __forceinline__ void operator()(const f32x4 (&acc)[2][2][4][2], const Unit& u, int wr, int wc, int fr, int fq, int ui, const PG8_LAS float* tab) const {
        if (V == 3) return;
        const int row0 = u.pm * BM + wr * 64 + fr; const int col0 = u.pn * BM + wc * 32 + 8 * fq;
#pragma unroll
        for (int ai = 0; ai < 2; ++ai)
#pragma unroll
            for (int m = 0; m < 4; ++m) { const int row = row0 + ai * HALF + m * 16; float rs = 1.f;
                if (V != 1) { const f32x4 p4 = *(const f32x4*)(stat + (size_t)row * 16 + 4 * fq); float s = (p4[0] + p4[1]) + (p4[2] + p4[3]); s += __shfl_xor(s, 16); s += __shfl_xor(s, 32); rs = __builtin_amdgcn_rsqf(s * inv_n + NORM_EPS); }
                bf16_t* rowp = O + (size_t)row * ldc + col0;
#pragma unroll
                for (int bj = 0; bj < 2; ++bj) { f32x4 v0 = acc[ai][bj][m][0] * rs, v1 = acc[ai][bj][m][1] * rs;
#pragma unroll
                    for (int e = 0; e < 4; ++e) { v0[e] = act_fn<1>(v0[e]); v1[e] = act_fn<1>(v1[e]); }
                    u32x4 w; w.x = pk2(v0[0], v0[1]); w.y = pk2(v0[2], v0[3]); w.z = pk2(v1[0], v1[1]); w.w = pk2(v1[2], v1[3]);
                    if (V != 2 || w.x == 0x7fc17fc1u) *(u32x4*)(rowp + bj * HALF) = w; } }
    }
};
template <int ACT, bool VSTAT, bool TILED = false> struct EpiCol {
    static constexpr bool PERM = true, AFTER_DRAIN = false, RELAX_OK = RELAX_DEFAULT;
    bf16_t* O; size_t ldc; const float* stat; float inv_n; float* vstat;
    template <class Sched> __device__ __forceinline__ void prepare(PG8_LAS float* tab, const Sched& S, int tid) const {
        Unit u;
#pragma unroll 4
        for (int ui = 0; S.next(ui, u); ++ui) { const f32x4* sp = (const f32x4*)(stat + (size_t)(u.pn * BM + (tid >> 1)) * 16 + (tid & 1) * 8); const f32x4 q = sp[0] + sp[1];
            float s = (q[0] + q[1]) + (q[2] + q[3]); s += __shfl_xor(s, 1); if (!(tid & 1)) tab[ui * 256 + (tid >> 1)] = __builtin_amdgcn_rsqf(s * inv_n + NORM_EPS); }
    }
    __device__ __forceinline__ void operator()(const f32x4 (&acc)[2][2][4][2], const Unit& u, int wr, int wc, int fr, int fq, int ui, const PG8_LAS float* tab) const {
        const int row0 = u.pm * BM + wr * 64 + fr; const int col0 = u.pn * BM + wc * 32 + 8 * fq;
        f32x4 rsv[2][2], sq[2][2];
#pragma unroll
        for (int bj = 0; bj < 2; ++bj)
#pragma unroll
            for (int n = 0; n < 2; ++n) { rsv[bj][n] = *(const PG8_LAS f32x4*)(tab + ui * 256 + wc * 32 + 8 * fq + bj * HALF + 4 * n); sq[bj][n] = (f32x4){0.f, 0.f, 0.f, 0.f}; }
#pragma unroll
        for (int ai = 0; ai < 2; ++ai)
#pragma unroll
            for (int m = 0; m < 4; ++m) { bf16_t* rowp = O + (size_t)(row0 + ai * HALF + m * 16) * ldc + col0;
#pragma unroll
                for (int bj = 0; bj < 2; ++bj) { f32x4 v0 = acc[ai][bj][m][0] * rsv[bj][0], v1 = acc[ai][bj][m][1] * rsv[bj][1];
#pragma unroll
                    for (int e = 0; e < 4; ++e) { v0[e] = act_fn<ACT>(v0[e]); v1[e] = act_fn<ACT>(v1[e]); }
                    if (VSTAT) { sq[bj][0] += v0 * v0; sq[bj][1] += v1 * v1; }
                    u32x4 w; w.x = pk2(v0[0], v0[1]); w.y = pk2(v0[2], v0[3]); w.z = pk2(v1[0], v1[1]); w.w = pk2(v1[2], v1[3]);
                    if (TILED) { const int ch = row0 + ai * HALF + m * 16, hd = ch >> 6, d = ch & 63, tk = col0 + bj * HALF, b = tk >> 11, sq = tk & 2047, kt = sq >> 5, k0 = sq & 31;
                        bf16_t* tp = O + ((size_t)(((b * 16 + hd) * 64 + kt)) << 11) + ((((d >> 5) * 2 + (k0 >> 4)) * 2 + ((k0 >> 3) & 1)) * 256) + (d & 31) * 4;
                        u32x2 lo, hi; lo.x = w.x; lo.y = w.y; hi.x = w.z; hi.y = w.w; ST8(tp, lo); ST8(tp + 128, hi); }
                    else ST16(rowp + bj * HALF, w); } }
        if (VSTAT) {
#pragma unroll
            for (int bj = 0; bj < 2; ++bj)
#pragma unroll
                for (int n = 0; n < 2; ++n)
#pragma unroll
                    for (int e = 0; e < 4; ++e) { float s = sq[bj][n][e]; s += __shfl_xor(s, 1); s += __shfl_xor(s, 2); s += __shfl_xor(s, 4); s += __shfl_xor(s, 8);
                        if (fr == bj * 8 + n * 4 + e) vstat[(size_t)(col0 + bj * HALF + 4 * n + e) * 16 + u.pm * 2 + wr] = s; }
        }
    }
};
#ifndef RES_LO
#define RES_LO 0
#endif
struct EpiRes {
    static constexpr bool PERM = true, AFTER_DRAIN = false, RELAX_OK = RELAX_DEFAULT;
    bf16_t* xb; bf16_t* xl; float* stat; int ldc;
    template <class Sched> __device__ __forceinline__ void prepare(PG8_LAS float*, const Sched&, int) const {}
    __device__ __forceinline__ void operator()(const f32x4 (&acc)[2][2][4][2], const Unit& u, int wr, int wc, int fr, int fq, int ui, const PG8_LAS float* tab) const {
        const int row0 = u.pm * BM + wr * 64 + fr; const int col0 = u.pn * BM + wc * 32 + 8 * fq;
#pragma unroll
        for (int ai = 0; ai < 2; ++ai) {
            u32x4 bh[4][2], bl[4][2];
#pragma unroll
            for (int m = 0; m < 4; ++m) { const size_t off = (size_t)(row0 + ai * HALF + m * 16) * ldc + col0;
#pragma unroll
                for (int bj = 0; bj < 2; ++bj) { bh[m][bj] = LD16R(xb + off + bj * HALF); bl[m][bj] = RES_LO ? LD16R(xl + off + bj * HALF) : (u32x4){0u, 0u, 0u, 0u}; } }
#pragma unroll
            for (int m = 0; m < 4; ++m) { const int row = row0 + ai * HALF + m * 16; const size_t off = (size_t)row * ldc + col0; float ss = 0.f;
#pragma unroll
                for (int bj = 0; bj < 2; ++bj) { const u32x4 h4 = bh[m][bj], l4 = bl[m][bj]; u32x4 wh, wl;
#pragma unroll
                    for (int e = 0; e < 4; ++e) { const int n = e >> 1, k = (e & 1) * 2;
                        const float x0 = __uint_as_float(h4[e] << 16) + __uint_as_float(l4[e] << 16) + acc[ai][bj][m][n][k];
                        const float x1 = __uint_as_float(h4[e] & 0xffff0000u) + __uint_as_float(l4[e] & 0xffff0000u) + acc[ai][bj][m][n][k + 1];
                        ss += x0 * x0 + x1 * x1;
                        const unsigned hw = pk2(x0, x1); wh[e] = hw;
                        wl[e] = pk2(x0 - __uint_as_float(hw << 16), x1 - __uint_as_float(hw & 0xffff0000u)); }
                    ST16R(xb + off + bj * HALF, wh); if (RES_LO) ST16L(xl + off + bj * HALF, wl); }
                ss += __shfl_xor(ss, 16); ss += __shfl_xor(ss, 32);
                if (fq == 0) stat[(size_t)row * 16 + u.pn * 4 + wc] = ss; }
        }
    }
};

template <class Epi, class Sched, bool ALIGN_EPI = false, bool SP2 = false>
__device__ __forceinline__ void gemm_phase(PG8_LAS unsigned char* lds, const Gemm g, const Sched& S0, const Epi& E) {
    PG8_LAS float* tab = (PG8_LAS float*)(lds + STAGE_BYTES + 1024);
    Sched S = S0; asm volatile("" : "+s"(S.c));
    int tid_ = threadIdx.x, K_ = g.K; asm volatile("" : "+v"(tid_), "+s"(K_));
    const int tid = tid_, wid = __builtin_amdgcn_readfirstlane(tid >> 6), lane = tid & 63, wr = wid >> 2, wc = wid & 3, fr = lane & 15, fq = lane >> 4;
    const int K = K_, nt = K / BK;
    unsigned voffA[2], voffB[2];
#pragma unroll
    for (int i = 0; i < 2; ++i) { int R, C; stage_rc(tid * 16 + i * 8192, R, C); const int Rb = Epi::PERM ? ((R & ~31) + perm32(R & 31)) : R;
        voffA[i] = (unsigned)(R * K + C) * 2u; voffB[i] = (unsigned)(Rb * K + C) * 2u; }
    const size_t kstep = (size_t)(BK * 2);
    const size_t hstep = (size_t)HALF * K * 2;
    const size_t tstep = 2 * hstep;
    const unsigned ldsw = (unsigned)wid * 1024u;
    const int aoff = lds_byte(wr * 64 + fr, fq * 8), boff = lds_byte(wc * 32 + fr, fq * 8);
#define PG8_SA(b, h) (((b) * 2 + (h)) * HTB)
#define PG8_SB(b, h) ((4 + (b) * 2 + (h)) * HTB)
#define PG8_STAGE(bufoff, gbase, voff) do { _Pragma("unroll") for (int _i = 0; _i < 2; ++_i) \
        __builtin_amdgcn_global_load_lds((const unsigned*)((const char*)(gbase) + (voff)[_i]), (PG8_LAS unsigned*)(lds + (bufoff) + ldsw + _i * 8192), 16, 0, 0); } while (0)
#define PG8_LDA(dst, b, h) do { _Pragma("unroll") for (int m = 0; m < 4; ++m) _Pragma("unroll") for (int k = 0; k < 2; ++k) dst[m][k] = *(const PG8_LAS bf16x8*)(lds + PG8_SA(b, h) + aoff + m * 2048 + k * 1024); } while (0)
#define PG8_LDB(dst, b, h) do { _Pragma("unroll") for (int n = 0; n < 2; ++n) _Pragma("unroll") for (int k = 0; k < 2; ++k) dst[n][k] = *(const PG8_LAS bf16x8*)(lds + PG8_SB(b, h) + boff + n * 2048 + k * 1024); } while (0)
#define PG8_MMA(ai, bj, At, Bt) do { __builtin_amdgcn_s_setprio(1); _Pragma("unroll") for (int m = 0; m < 4; ++m) _Pragma("unroll") for (int n = 0; n < 2; ++n) _Pragma("unroll") for (int k = 0; k < 2; ++k) \
        acc[ai][bj][m][n] = __builtin_amdgcn_mfma_f32_16x16x32_bf16(Bt[n][k], At[m][k], acc[ai][bj][m][n], 0, 0, 0); __builtin_amdgcn_s_setprio(0); } while (0)
#define PG8_WAIT_V(n) asm volatile("s_waitcnt vmcnt(" #n ")" ::: "memory")
#define PG8_WAIT_L(n) asm volatile("s_waitcnt lgkmcnt(" #n ")" ::: "memory")
#define PG8_BAR __builtin_amdgcn_s_barrier()
#define PG8_SCHED __builtin_amdgcn_sched_barrier(0)
    Unit cur, nxt; int ui = 0;
    if (!S.next(0, cur)) return;
    E.prepare(tab, S, tid); __syncthreads();
    f32x4 acc[2][2][4][2];
#pragma unroll
    for (int a = 0; a < 2; ++a)
#pragma unroll
        for (int b = 0; b < 2; ++b)
#pragma unroll
            for (int m = 0; m < 4; ++m)
#pragma unroll
                for (int n = 0; n < 2; ++n) acc[a][b][m][n] = (f32x4){0.f, 0.f, 0.f, 0.f};
    bf16x8 At[4][2], B0[2][2], B1[2][2];
    const char* cA = (const char*)g.A + (size_t)cur.pm * tstep; const char* cB = (const char*)g.Bt + (size_t)cur.pn * tstep;
    S.a_ready(cur);
    if constexpr (SP2) {
        PG8_STAGE(PG8_SB(0, 0), cB, voffB); PG8_STAGE(PG8_SB(0, 1), cB + hstep, voffB); PG8_STAGE(PG8_SA(0, 0), cA, voffA); PG8_STAGE(PG8_SA(0, 1), cA + hstep, voffA);
        if (wr == 1) PG8_BAR;
        PG8_WAIT_V(2); PG8_BAR;
        PG8_STAGE(PG8_SB(1, 0), cB + kstep, voffB); PG8_STAGE(PG8_SA(1, 0), cA + kstep, voffA); PG8_STAGE(PG8_SB(1, 1), cB + hstep + kstep, voffB);
        PG8_WAIT_V(6); PG8_BAR;
    } else {
        PG8_STAGE(PG8_SB(0, 0), cB, voffB); PG8_STAGE(PG8_SA(0, 0), cA, voffA); PG8_STAGE(PG8_SB(0, 1), cB + hstep, voffB); PG8_STAGE(PG8_SA(0, 1), cA + hstep, voffA);
        if (wr == 1) PG8_BAR;
        PG8_WAIT_V(4); PG8_BAR;
        PG8_STAGE(PG8_SB(1, 0), cB + kstep, voffB); PG8_STAGE(PG8_SA(1, 0), cA + kstep, voffA); PG8_STAGE(PG8_SB(1, 1), cB + hstep + kstep, voffB);
        PG8_WAIT_V(6); PG8_BAR;
    }
    for (;;) {
        const bool has_next = S.next(ui + 1, nxt);
        const char* nA = has_next ? (const char*)g.A + (size_t)nxt.pm * tstep : cA; const char* nB = has_next ? (const char*)g.Bt + (size_t)nxt.pn * tstep : cB;
        for (int t = 0; t < nt; t += 2) {
            const bool last = (t == nt - 2);
            const char* a1 = cA + (size_t)(t + 1) * kstep;
            const char* a2 = last ? nA : cA + (size_t)(t + 2) * kstep; const char* b2 = last ? nB : cB + (size_t)(t + 2) * kstep;
            const char* a3 = a2 + kstep; const char* b3 = b2 + kstep;
            if (last && has_next) S.a_ready(nxt);
            if constexpr (SP2) {
            const int relax = __builtin_amdgcn_readfirstlane((Epi::RELAX_OK && (t == 0) && (ui > 0)) ? 1 : 0);
            PG8_LDB(B0, 0, 0); PG8_LDB(B1, 0, 1); PG8_SCHED; PG8_LDA(At, 0, 0); PG8_STAGE(PG8_SA(1, 1), a1 + hstep, voffA);
            asm volatile("s_cmp_lg_u32 %0, 0\n\ts_cbranch_scc1 1\n\ts_waitcnt vmcnt(8)" :: "s"(relax) : "memory", "scc");
            PG8_WAIT_L(0); PG8_BAR; PG8_MMA(0, 0, At, B0); PG8_MMA(0, 1, At, B1); PG8_BAR; PG8_SCHED;
            PG8_LDA(At, 0, 1); PG8_STAGE(PG8_SB(0, 0), b2, voffB); PG8_STAGE(PG8_SB(0, 1), b2 + hstep, voffB); PG8_STAGE(PG8_SA(0, 0), a2, voffA);
            asm volatile("s_cmp_lg_u32 %0, 0\n\ts_cbranch_scc1 1\n\ts_waitcnt vmcnt(8)" :: "s"(relax) : "memory", "scc");
            PG8_WAIT_L(0); PG8_BAR; PG8_MMA(1, 0, At, B0); PG8_MMA(1, 1, At, B1); PG8_BAR; PG8_SCHED;
            PG8_LDB(B0, 1, 0); PG8_LDB(B1, 1, 1); PG8_SCHED; PG8_LDA(At, 1, 0); PG8_STAGE(PG8_SA(0, 1), a2 + hstep, voffA);
            PG8_WAIT_V(8); PG8_WAIT_L(0); PG8_BAR; PG8_MMA(0, 0, At, B0); PG8_MMA(0, 1, At, B1); PG8_BAR; PG8_SCHED;
            PG8_LDA(At, 1, 1); PG8_STAGE(PG8_SB(1, 0), b3, voffB); PG8_STAGE(PG8_SB(1, 1), b3 + hstep, voffB); PG8_STAGE(PG8_SA(1, 0), a3, voffA);
            PG8_WAIT_V(8); PG8_WAIT_L(0); PG8_BAR; PG8_MMA(1, 0, At, B0); PG8_MMA(1, 1, At, B1); PG8_BAR; PG8_SCHED;
            } else {
            PG8_LDB(B0, 0, 0); PG8_SCHED; PG8_LDA(At, 0, 0); PG8_STAGE(PG8_SA(1, 1), a1 + hstep, voffA);
            PG8_WAIT_L(8); PG8_BAR; PG8_WAIT_L(0); PG8_MMA(0, 0, At, B0); PG8_BAR; PG8_SCHED;
            PG8_LDB(B1, 0, 1); PG8_STAGE(PG8_SB(0, 0), b2, voffB);
            PG8_BAR; PG8_WAIT_L(0); PG8_MMA(0, 1, At, B1); PG8_BAR;
            PG8_LDA(At, 0, 1); PG8_STAGE(PG8_SA(0, 0), a2, voffA);
            PG8_BAR; PG8_WAIT_L(0); PG8_MMA(1, 0, At, B0); PG8_BAR; PG8_SCHED;
            PG8_STAGE(PG8_SB(0, 1), b2 + hstep, voffB);
            PG8_WAIT_V(6); PG8_BAR; PG8_MMA(1, 1, At, B1); PG8_BAR;
            PG8_LDB(B0, 1, 0); PG8_SCHED; PG8_LDA(At, 1, 0); PG8_STAGE(PG8_SA(0, 1), a2 + hstep, voffA);
            PG8_WAIT_L(8); PG8_BAR; PG8_WAIT_L(0); PG8_MMA(0, 0, At, B0); PG8_BAR; PG8_SCHED;
            PG8_LDB(B1, 1, 1); PG8_STAGE(PG8_SB(1, 0), b3, voffB);
            PG8_BAR; PG8_WAIT_L(0); PG8_MMA(0, 1, At, B1); PG8_BAR;
            PG8_LDA(At, 1, 1); PG8_STAGE(PG8_SA(1, 0), a3, voffA);
            PG8_BAR; PG8_WAIT_L(0); PG8_MMA(1, 0, At, B0); PG8_BAR; PG8_SCHED;
            PG8_STAGE(PG8_SB(1, 1), b3 + hstep, voffB);
            PG8_WAIT_V(6); PG8_BAR; PG8_MMA(1, 1, At, B1); PG8_BAR;
            }
        }
        if constexpr (ALIGN_EPI) { if (wr == 0) PG8_BAR; }
        if constexpr (!Epi::AFTER_DRAIN) { E(acc, cur, wr, wc, fr, fq, ui, tab); S.done(cur); }
        if (!has_next) break;
#pragma unroll
        for (int a = 0; a < 2; ++a)
#pragma unroll
            for (int b = 0; b < 2; ++b)
#pragma unroll
                for (int m = 0; m < 4; ++m)
#pragma unroll
                    for (int n = 0; n < 2; ++n) acc[a][b][m][n] = (f32x4){0.f, 0.f, 0.f, 0.f};
        cur = nxt; cA = nA; cB = nB; ++ui;
        if constexpr (ALIGN_EPI) { if (wr == 1) PG8_BAR; }
    }
    PG8_WAIT_V(0);
    if constexpr (!ALIGN_EPI) { if (wr == 0) PG8_BAR; }
    PG8_BAR;
    if constexpr (Epi::AFTER_DRAIN) { E.fused(acc, cur, wr, wc, fr, fq, lds, wid, lane); S.done(cur); }
#undef PG8_SA
#undef PG8_SB
#undef PG8_STAGE
#undef PG8_LDA
#undef PG8_LDB
#undef PG8_MMA
#undef PG8_WAIT_V
#undef PG8_WAIT_L
#undef PG8_BAR
#undef PG8_SCHED
}
}
#define LAS __attribute__((address_space(3)))
typedef unsigned short bf16_t;
typedef short bf16x8 __attribute__((ext_vector_type(8)));
typedef short s16x4 __attribute__((ext_vector_type(4)));
typedef float f32x4 __attribute__((ext_vector_type(4)));
typedef float f32x16 __attribute__((ext_vector_type(16)));
typedef unsigned u32x4 __attribute__((ext_vector_type(4)));
using pg8::u32x2;
using pg8::pk2;
#ifndef PG_ALIGN
#define PG_ALIGN true
#endif
#ifndef PG_SP2
#define PG_SP2 true
#endif
#define MFMA32(a, b, c) __builtin_amdgcn_mfma_f32_32x32x16_bf16((a), (b), (c), 0, 0, 0)
#define LDS_WAIT() asm volatile("s_waitcnt lgkmcnt(0)" ::: "memory")

constexpr int BATCH = 32, SEQ = 2048, D = 1024, M = BATCH * SEQ, DEPTH = 4, NH = 16, HD = 64, FF = 4096, SF = 2048, SG = 8, SC = 128, SGW = 256;
constexpr float EPS = 1e-6f;
constexpr float QSCALE = 0.125f * 1.4426950408889634f;
constexpr size_t MiB = 1u << 20;
constexpr size_t WS_WQKV = 4 * MiB;
constexpr size_t WS_WO = 16 * MiB;
constexpr size_t WS_WIN = 20 * MiB;
constexpr size_t WS_WOUT = 36 * MiB;
constexpr size_t WS_W1 = 44 * MiB;
constexpr size_t WS_W2 = 76 * MiB;
constexpr size_t WS_XB = 112 * MiB;
constexpr size_t WS_BIG = 240 * MiB;
constexpr size_t PV = (size_t)M + 128;
constexpr size_t WS_STAT = 756 * MiB;
constexpr size_t STAT_ELEMS = (size_t)M * 16;
constexpr size_t WS_XL = 800 * MiB;
constexpr size_t WS_END = 928 * MiB;
constexpr int LDS_BYTES = 155648;

__device__ __forceinline__ int crow(int reg, int h) { return (reg & 3) + 8 * (reg >> 2) + 4 * h; }
__device__ __forceinline__ float wave_sum(float v) {
#pragma unroll
    for (int o = 1; o < 64; o <<= 1) v += __shfl_xor(v, o);
    return v;
}
__device__ __forceinline__ float bf2f(bf16_t v) { return __uint_as_float((unsigned)v << 16); }
__device__ __forceinline__ bf16_t f2bf(float v) { return (bf16_t)(pk2(v, 0.f) & 0xffffu); }

typedef __attribute__((address_space(1))) unsigned gu32;
#define XB_TMO      128
#define XB_XCNT(j)  (256  + 64 * (j))
#define XB_XSUB(j)  (1280 + 64 * (j))
#define XB_XGEN(j)  (2304 + 64 * (j))
#define XB_TOP      3328
#define XB_TOPGEN   3392
#define XCD_BAR_WORDS 3456
#define XB_SPIN_CAP (1u << 18)

__device__ __forceinline__ unsigned xb_ld(unsigned* p)              { return __hip_atomic_load(p, __ATOMIC_RELAXED, __HIP_MEMORY_SCOPE_AGENT); }
__device__ __forceinline__ unsigned xb_add(unsigned* p, unsigned v) { return __hip_atomic_fetch_add(p, v, __ATOMIC_RELAXED, __HIP_MEMORY_SCOPE_AGENT); }
__device__ __forceinline__ unsigned xb_xcc_id() { return (unsigned)__builtin_amdgcn_s_getreg((3 << 11) | 20) & 0xFu; }
#define XB_SPIN(cond, bar) do { unsigned _sp = 0; while (cond) { __builtin_amdgcn_s_sleep(1); \
    if ((++_sp & 255u) == 0u) { if (xb_ld(&(bar)[XB_TMO])) break; if (_sp > XB_SPIN_CAP) { atomicAdd(&(bar)[XB_TMO], 1u); break; } } } } while (0)

struct XcdBarrier {
    unsigned* bar; unsigned x;
    volatile LAS unsigned* st;
};

__device__ __forceinline__ XcdBarrier xcd_barrier_post(unsigned* bar, volatile LAS unsigned* st) {
    XcdBarrier b; b.bar = bar; b.x = xb_xcc_id(); b.st = st;
    if (threadIdx.x == 0) (void)xb_add(&bar[XB_XCNT(b.x)], 1u);
    return b;
}
__device__ __forceinline__ void xcd_barrier_complete(unsigned* bar, unsigned x, unsigned& nloc, unsigned& nx) {
    const unsigned G = gridDim.x * gridDim.y * gridDim.z;
    unsigned sum, cnt, mine, sp = 0u;
    for (;;) {
        sum = 0u; cnt = 0u; mine = 0u;
#pragma unroll
        for (unsigned j = 0; j < 16; ++j) { const unsigned c = xb_ld(&bar[XB_XCNT(j)]); sum += c; cnt += (c > 0u) ? 1u : 0u; mine = (j == x) ? c : mine; }
        if (sum == G) break;
        __builtin_amdgcn_s_sleep(1);
        if ((++sp & 255u) == 0u) { if (xb_ld(&bar[XB_TMO])) break; if (sp > XB_SPIN_CAP) { atomicAdd(&bar[XB_TMO], 1u); break; } }
    }
    nloc = mine > 0u ? mine : 1u; nx = cnt > 0u ? cnt : 1u;
}

__device__ __forceinline__ void xcd_barrier(const XcdBarrier& b) {
    asm volatile("s_waitcnt vmcnt(0)" ::: "memory");
    __syncthreads();
    if (threadIdx.x == 0) {
        unsigned* bar = b.bar;
        __builtin_amdgcn_s_waitcnt(0);
        unsigned nloc = b.st[0], nx = b.st[1];
        if (nloc == 0u) { xcd_barrier_complete(bar, b.x, nloc, nx); b.st[0] = nloc; b.st[1] = nx; }
        const unsigned old = xb_add(&bar[XB_XSUB(b.x)], 1u);
        const unsigned gen = old / nloc;
        if (old + 1u == (gen + 1u) * nloc) {
            __builtin_amdgcn_fence(__ATOMIC_RELEASE, "agent");
            asm volatile("s_waitcnt vmcnt(0)" ::: "memory");
            const unsigned og = xb_add(&bar[XB_TOP], 1u);
            const unsigned tg = og / nx;
            if (og + 1u == (tg + 1u) * nx) xb_add(&bar[XB_TOPGEN], 1u);
            else XB_SPIN(xb_ld(&bar[XB_TOPGEN]) == tg, bar);
            __builtin_amdgcn_fence(__ATOMIC_ACQUIRE, "agent");
            xb_add(&bar[XB_XGEN(b.x)], 1u);
            asm volatile("s_waitcnt vmcnt(0)" ::: "memory");
        } else {
            XB_SPIN(xb_ld(&bar[XB_XGEN(b.x)]) == gen, bar);
            __builtin_amdgcn_fence(__ATOMIC_ACQUIRE, "agent");
            asm volatile("s_waitcnt vmcnt(0)" ::: "memory");
        }
    }
    __syncthreads();
}

#ifdef NT_P0
#define P0LD(p) __builtin_nontemporal_load(p)
#else
#define P0LD(p) (*(p))
#endif
__device__ __forceinline__ void tr_item(const float* W, const float* gain, int K, int N, bf16_t* WT, LAS float* scr, int item, int lane) {
    const int nblk = N / 32, kb = item / nblk, nb = item % nblk, k0 = 64 * kb, n0 = 32 * nb;
    float wv[32];
#pragma unroll
    for (int i = 0; i < 32; ++i) wv[i] = P0LD(&W[(size_t)(k0 + 2 * i + (lane >> 5)) * N + n0 + (lane & 31)]);
    if (gain) {
#pragma unroll
        for (int i = 0; i < 32; ++i) wv[i] *= gain[k0 + 2 * i + (lane >> 5)]; }
#pragma unroll
    for (int i = 0; i < 32; ++i) scr[(2 * i + (lane >> 5)) * 33 + (lane & 31)] = wv[i];
    LDS_WAIT(); asm volatile("" ::: "memory");
    const int c = lane & 7;
#pragma unroll
    for (int jj = 0; jj < 4; ++jj) { const int n = (lane >> 3) + 8 * jj; const LAS float* s = scr + (8 * c) * 33 + n;
        u32x4 o; o.x = pk2(s[0 * 33], s[1 * 33]); o.y = pk2(s[2 * 33], s[3 * 33]); o.z = pk2(s[4 * 33], s[5 * 33]); o.w = pk2(s[6 * 33], s[7 * 33]);
#ifdef NT2
        __builtin_nontemporal_store(o, (u32x4*)(WT + (size_t)(n0 + n) * K + k0 + 8 * c)); }
#else
        *(u32x4*)(WT + (size_t)(n0 + n) * K + k0 + 8 * c) = o; }
#endif
    LDS_WAIT(); asm volatile("" ::: "memory");
}

struct Args { const float* in[13]; float* out; unsigned char* ws; };

#define OPAQUE_IDS() int tid_ = threadIdx.x, bx_ = blockIdx.x; asm volatile("" : "+v"(tid_), "+s"(bx_)); const int tid = tid_, lane = tid & 63, wave = __builtin_amdgcn_readfirstlane(tid >> 6); \
    const int G = gridDim.x, vcu = (G % 8 == 0) ? (bx_ % 8) * (G / 8) + bx_ / 8 : bx_; (void)tid; (void)lane; (void)wave; (void)vcu
__device__ __forceinline__ void p0_prologue(const Args& a, LAS unsigned char* lds) {
    OPAQUE_IDS();
    unsigned char* ws = a.ws;
    LAS float* scr = (LAS float*)(lds + wave * 16384);
    const int gw = vcu * 8 + wave, NGW = G * 8;
    constexpr int I_QKV = 16 * 96, I_O = 16 * 32, I_IN = 16 * 128, I_OUT = 32 * 32, I_1 = 16 * 128, I_2 = 64 * 32;
    constexpr int NITEMS = 2 * I_QKV + 2 * I_O + 2 * I_IN + 2 * I_OUT + 4 * I_1 + 4 * I_2;
    for (int it = gw; it < NITEMS; it += NGW) {
        int r = it; const float* W; const float* gain = nullptr; int K, N; bf16_t* WT;
        if (r < 2 * I_QKV) { const int j = r / I_QKV; r -= j * I_QKV; W = a.in[3] + (size_t)j * D * 3 * D; gain = a.in[1] + (size_t)(2 * j) * D; K = D; N = 3 * D; WT = (bf16_t*)(ws + WS_WQKV) + (size_t)j * 3 * D * D; }
        else if ((r -= 2 * I_QKV) < 2 * I_O) { const int j = r / I_O; r -= j * I_O; W = a.in[4] + (size_t)j * D * D; K = D; N = D; WT = (bf16_t*)(ws + WS_WO) + (size_t)j * D * D; }
        else if ((r -= 2 * I_O) < 2 * I_IN) { const int j = r / I_IN; r -= j * I_IN; W = a.in[5] + (size_t)j * D * 2 * SF; gain = a.in[1] + (size_t)(2 * j + 1) * D; K = D; N = 2 * SF; WT = (bf16_t*)(ws + WS_WIN) + (size_t)j * 2 * SF * D; }
        else if ((r -= 2 * I_IN) < 2 * I_OUT) { const int j = r / I_OUT; r -= j * I_OUT; W = a.in[9] + (size_t)j * SF * D; K = SF; N = D; WT = (bf16_t*)(ws + WS_WOUT) + (size_t)j * D * SF; }
        else if ((r -= 2 * I_OUT) < 4 * I_1) { const int j = r / I_1; r -= j * I_1; W = a.in[10] + (size_t)j * D * FF; gain = a.in[2] + (size_t)j * D; K = D; N = FF; WT = (bf16_t*)(ws + WS_W1) + (size_t)j * FF * D; }
        else { r -= 4 * I_1; const int j = r / I_2; r -= j * I_2; W = a.in[11] + (size_t)j * FF * D; K = FF; N = D; WT = (bf16_t*)(ws + WS_W2) + (size_t)j * D * FF; }
        tr_item(W, gain, K, N, WT, scr, r, lane);
    }
    const float* x = a.in[0]; bf16_t* XB = (bf16_t*)(ws + WS_XB); bf16_t* XL = (bf16_t*)(ws + WS_XL); float* stat = (float*)(ws + WS_STAT);
    for (int m0 = gw; m0 < M; m0 += 4 * NGW) {
        f32x4 v[4][4];
#pragma unroll
        for (int q = 0; q < 4; ++q) { const int m = m0 + q * NGW; const f32x4* xr = (const f32x4*)(x + (size_t)(m < M ? m : m0) * D) + lane;
#pragma unroll
            for (int jj = 0; jj < 4; ++jj) v[q][jj] = P0LD(&xr[64 * jj]); }
#pragma unroll
        for (int q = 0; q < 4; ++q) { const int m = m0 + q * NGW; if (m >= M) break; float s = 0.f;
#pragma unroll
            for (int jj = 0; jj < 4; ++jj) s += (v[q][jj].x * v[q][jj].x + v[q][jj].y * v[q][jj].y) + (v[q][jj].z * v[q][jj].z + v[q][jj].w * v[q][jj].w);
            s = wave_sum(s); if (lane < 16) stat[(size_t)m * 16 + lane] = (lane == 0) ? s : 0.f;
            u32x2* o8 = (u32x2*)(XB + (size_t)m * D) + lane; u32x2* l8 = (u32x2*)(XL + (size_t)m * D) + lane;
#pragma unroll
            for (int jj = 0; jj < 4; ++jj) { u32x2 w, l; w.x = pk2(v[q][jj].x, v[q][jj].y); w.y = pk2(v[q][jj].z, v[q][jj].w);
                l.x = pk2(v[q][jj].x - __uint_as_float(w.x << 16), v[q][jj].y - __uint_as_float(w.x & 0xffff0000u));
                l.y = pk2(v[q][jj].z - __uint_as_float(w.y << 16), v[q][jj].w - __uint_as_float(w.y & 0xffff0000u));
#ifdef NT2
                __builtin_nontemporal_store(w, &o8[64 * jj]); __builtin_nontemporal_store(l, &l8[64 * jj]);
#else
                o8[64 * jj] = w; if (RES_LO) l8[64 * jj] = l;
#endif
            } }
    }
}

__device__ __forceinline__ void attn_phase(const bf16_t* __restrict__ Q, const bf16_t* __restrict__ Kb, const bf16_t* __restrict__ VT, bf16_t* __restrict__ O) {
    OPAQUE_IDS();
    const int r = lane & 31, h = lane >> 5;
    for (int u = vcu; u < BATCH * NH * (SEQ / 256); u += G) {
        const int qb = u & 7, bh = u >> 3, hh = bh & 15, b = bh >> 4;
        const int t0 = qb * 256 + wave * 32;
        const size_t rowb = (size_t)b * SEQ;
        const size_t tile0 = (size_t)((b * NH + hh) * (SEQ / 32)) << 11;
        bf16x8 qf[4];
        { const bf16_t* qp = Q + tile0 + ((size_t)(t0 >> 5) << 11) + lane * 8;
#pragma unroll
          for (int d0 = 0; d0 < 4; ++d0) qf[d0] = *(const bf16x8*)(qp + d0 * 512); }
        f32x16 o0, o1;
#pragma unroll
        for (int i = 0; i < 16; ++i) { o0[i] = 0.f; o1[i] = 0.f; }
        float carry = 1.f;
        const bf16_t* kbase = Kb + tile0 + lane * 8;
        const bf16_t* vbase = VT + tile0 + lane * 4;
        bf16x8 kf[4]; s16x4 va[2][2][2];
#define ATT_LOAD(KF, VA, s0_) do { const bf16_t* kp_ = kbase + ((size_t)((s0_) >> 5) << 11); const bf16_t* vp_ = vbase + ((size_t)((s0_) >> 5) << 11); \
        _Pragma("unroll") for (int d0 = 0; d0 < 4; ++d0) KF[d0] = *(const bf16x8*)(kp_ + d0 * 512); \
        _Pragma("unroll") for (int db = 0; db < 2; ++db) _Pragma("unroll") for (int s = 0; s < 2; ++s) { VA[db][s][0] = *(const s16x4*)(vp_ + ((db * 2 + s) * 2 + 0) * 256); VA[db][s][1] = *(const s16x4*)(vp_ + ((db * 2 + s) * 2 + 1) * 256); } } while (0)
        ATT_LOAD(kf, va, t0);
        bf16x8 kn[4]; s16x4 vn[2][2][2];
        { const int sn = t0 >= 32 ? t0 - 32 : 0; ATT_LOAD(kn, vn, sn); }
        for (int kt = t0 >> 5; kt >= 0; --kt) {
            const int s0 = kt * 32;
            bf16x8 k2[4]; s16x4 v2[2][2][2];
            { const int sn = kt > 1 ? s0 - 64 : 0; ATT_LOAD(k2, v2, sn); }
            f32x16 X;
#pragma unroll
            for (int i = 0; i < 16; ++i) X[i] = 0.f;
#pragma unroll
            for (int d0 = 0; d0 < 4; ++d0) X = MFMA32(kf[d0], qf[d0], X);
            const bool diag = (s0 == t0);
            float Ev[16], Dv[16], A[16];
#pragma unroll
            for (int i = 0; i < 16; ++i) { const float z = fminf(X[i], 31.f); float E = __builtin_amdgcn_exp2f(z);
                if (diag) E = (crow(i, h) < r) ? E : 0.f;
                Ev[i] = E; Dv[i] = 1.f + E; }
            float gp[4], og[4];
#pragma unroll
            for (int g = 0; g < 4; ++g) { gp[g] = __builtin_amdgcn_rcpf((Dv[4 * g] * Dv[4 * g + 1]) * (Dv[4 * g + 2] * Dv[4 * g + 3])); og[g] = __shfl_xor(gp[g], 32); }
            float sp = carry;
#pragma unroll
            for (int g = 3; g >= 0; --g) { const float gs = (h == 0) ? sp * og[g] : sp;
                const float gi = gs * gp[g], t1 = gi * Dv[4 * g], t2 = t1 * Dv[4 * g + 1], t3 = t2 * Dv[4 * g + 2];
                A[4 * g] = Ev[4 * g] * gi; A[4 * g + 1] = Ev[4 * g + 1] * t1; A[4 * g + 2] = Ev[4 * g + 2] * t2; A[4 * g + 3] = Ev[4 * g + 3] * t3;
                sp *= gp[g] * og[g]; }
            carry = sp;
            bf16x8 pf[2];
#pragma unroll
            for (int s = 0; s < 2; ++s) { u32x4 p; p.x = pk2(A[8 * s], A[8 * s + 1]); p.y = pk2(A[8 * s + 2], A[8 * s + 3]); p.z = pk2(A[8 * s + 4], A[8 * s + 5]); p.w = pk2(A[8 * s + 6], A[8 * s + 7]); pf[s] = __builtin_bit_cast(bf16x8, p); }
#pragma unroll
            for (int s = 0; s < 2; ++s) {
                const bf16x8 v0 = __builtin_shufflevector(va[0][s][0], va[0][s][1], 0, 1, 2, 3, 4, 5, 6, 7);
                const bf16x8 v1 = __builtin_shufflevector(va[1][s][0], va[1][s][1], 0, 1, 2, 3, 4, 5, 6, 7);
                o0 = MFMA32(pf[s], v0, o0); o1 = MFMA32(pf[s], v1, o1); }
            if (__builtin_amdgcn_ballot_w64(carry >= 1.17549435e-38f) == 0ull) break;
#pragma unroll
            for (int d0 = 0; d0 < 4; ++d0) { kf[d0] = kn[d0]; kn[d0] = k2[d0]; }
#pragma unroll
            for (int db = 0; db < 2; ++db)
#pragma unroll
                for (int s = 0; s < 2; ++s) { va[db][s][0] = vn[db][s][0]; va[db][s][1] = vn[db][s][1]; vn[db][s][0] = v2[db][s][0]; vn[db][s][1] = v2[db][s][1]; }
        }
#undef ATT_LOAD
        bf16_t* op = O + (rowb + t0) * D + hh * HD + r;
#pragma unroll
        for (int i = 0; i < 16; ++i) { const size_t ro = (size_t)crow(i, h) * D;
#ifdef NT2
            __builtin_nontemporal_store(f2bf(o0[i]), op + ro); __builtin_nontemporal_store(f2bf(o1[i]), op + ro + 32);
#else
            op[ro] = f2bf(o0[i]); op[ro + 32] = f2bf(o1[i]);
#endif
        }
    }
}

#define MFMA16(a, b, c) __builtin_amdgcn_mfma_f32_16x16x32_bf16((a), (b), (c), 0, 0, 0)
template <bool REAL> __device__ __forceinline__ void sgu_mix_phase(LAS unsigned char* lds, const float* wsj, const float* bsj, const float* gainj, const float* vstat, const bf16_t* VT2, bf16_t* UY) {
    OPAQUE_IDS();
    const int q = lane >> 4, tl = lane & 15;
    constexpr int ROWB = 272, NU = BATCH * (SEQ / SC) * SG;
    LAS float* rsT = (LAS float*)(lds + 128 * ROWB);
    const int g = vcu & 7;
    const int c0 = g * SGW + wave * 32;
    const int c4 = (tid & 31) * 4;
    f32x4 wsr[8];
    { const float* wsg = wsj + (size_t)g * SC * SC;
#pragma unroll
      for (int it = 0; it < 8; ++it) wsr[it] = *(const f32x4*)(wsg + ((tid >> 5) + 16 * it) * SC + c4); }
    const f32x4 g0 = *(const f32x4*)(gainj + c0 + 8 * q), g1 = *(const f32x4*)(gainj + c0 + 8 * q + 4);
    bf16x8 va[4][2]; u32x4 uu[8]; f32x4 vs4;
#ifdef NT2
#define MIXLD(T, p) __builtin_nontemporal_load((const T*)(p))
#else
#define MIXLD(T, p) (*(const T*)(p))
#endif
#define MIX_LOAD(VA, UU, VS, u_) do { const size_t tok0_ = (size_t)((u_) >> 3) * SC; \
        const bf16_t* vp_ = VT2 + (size_t)(c0 + 8 * (tl >> 2) + (tl & 3)) * PV + tok0_ + q * 8; \
        _Pragma("unroll") for (int ks = 0; ks < 4; ++ks) { VA[ks][0] = MIXLD(bf16x8, vp_ + ks * 32); VA[ks][1] = MIXLD(bf16x8, vp_ + 4 * PV + ks * 32); } \
        const bf16_t* up_ = UY + (tok0_ + tl) * SF + c0 + 8 * q; \
        _Pragma("unroll") for (int tb = 0; tb < 8; ++tb) UU[tb] = MIXLD(u32x4, up_ + (size_t)tb * 16 * SF); \
        VS = *(const f32x4*)(vstat + (tok0_ + (tid >> 2)) * 16 + (tid & 3) * 4); } while (0)
    if ((G & 7) != 0) return;
    if (vcu < NU) MIX_LOAD(va, uu, vs4, vcu);
    for (int u = vcu; u < NU; u += G) {
        const size_t tok0 = (size_t)(u >> 3) * SC;
        { float sq = (vs4[0] + vs4[1]) + (vs4[2] + vs4[3]); sq += __shfl_xor(sq, 1); sq += __shfl_xor(sq, 2);
          if ((tid & 3) == 0) rsT[tid >> 2] = __builtin_amdgcn_rsqf(sq * (1.f / SF) + EPS); }
        bf16x8 vn[4][2]; u32x4 un[8]; f32x4 vsn;
        { const int un_ = (u + G < NU) ? u + G : u; MIX_LOAD(vn, un, vsn, un_); }
        __syncthreads();
        { const f32x4 rs = *(const LAS f32x4*)(rsT + c4);
#pragma unroll
          for (int it = 0; it < 8; ++it) { const int t = (tid >> 5) + 16 * it; const f32x4 w = wsr[it];
              const float a0 = (c4 + 0 <= t) ? w[0] * rs[0] : 0.f, a1 = (c4 + 1 <= t) ? w[1] * rs[1] : 0.f, a2 = (c4 + 2 <= t) ? w[2] * rs[2] : 0.f, a3 = (c4 + 3 <= t) ? w[3] * rs[3] : 0.f;
              u32x2 p; p.x = pk2(a0, a1); p.y = pk2(a2, a3); *(LAS u32x2*)(lds + t * ROWB + c4 * 2) = p; } }
        __syncthreads();
        bf16_t* up = UY + (tok0 + tl) * SF + c0 + 8 * q;
#pragma unroll
        for (int tb = 0; tb < 8; ++tb) {
            f32x4 a0 = {0.f, 0.f, 0.f, 0.f}, a1 = {0.f, 0.f, 0.f, 0.f};
#pragma unroll
            for (int ks = 0; ks <= (tb >> 1); ++ks) { const bf16x8 bfr = *(const LAS bf16x8*)(lds + (tb * 16 + tl) * ROWB + (ks * 32 + q * 8) * 2);
                a0 = MFMA16(va[ks][0], bfr, a0); a1 = MFMA16(va[ks][1], bfr, a1); }
            const float bsv = bsj[g * SC + tb * 16 + tl];
            const u32x4 w = uu[tb]; u32x4 o;
            o.x = pk2(__uint_as_float(w.x << 16) * (g0[0] * a0[0] + bsv), __uint_as_float(w.x & 0xffff0000u) * (g0[1] * a0[1] + bsv));
            o.y = pk2(__uint_as_float(w.y << 16) * (g0[2] * a0[2] + bsv), __uint_as_float(w.y & 0xffff0000u) * (g0[3] * a0[3] + bsv));
            o.z = pk2(__uint_as_float(w.z << 16) * (g1[0] * a1[0] + bsv), __uint_as_float(w.z & 0xffff0000u) * (g1[1] * a1[1] + bsv));
            o.w = pk2(__uint_as_float(w.w << 16) * (g1[2] * a1[2] + bsv), __uint_as_float(w.w & 0xffff0000u) * (g1[3] * a1[3] + bsv));
            if (REAL || o.x == 0x12345678u) {
#if 1
                __builtin_nontemporal_store(o, (u32x4*)(up + (size_t)tb * 16 * SF));
#else
                *(u32x4*)(up + (size_t)tb * 16 * SF) = o;
#endif
            }
        }
#pragma unroll
        for (int ks = 0; ks < 4; ++ks) { va[ks][0] = vn[ks][0]; va[ks][1] = vn[ks][1]; }
#pragma unroll
        for (int tb = 0; tb < 8; ++tb) uu[tb] = un[tb];
        vs4 = vsn;
    }
#undef MIX_LOAD
}

#ifdef TSEL
#define STAMP(id) do { const unsigned long long tn_ = __builtin_amdgcn_s_memrealtime(); if ((((unsigned)TSEL) >> (id)) & 1u) tsum += tn_ - tprev; tprev = tn_; } while (0)
#else
#define STAMP(id) do { } while (0)
#endif
struct FastSync { XcdBarrier b; __device__ __forceinline__ void sync() const { xcd_barrier(b); } };
template <int PAR> __device__ __forceinline__ void layer_fwd(const Args& a, const FastSync& grid, LAS unsigned char* lds, const int i, unsigned long long& tprev, unsigned long long& tsum) {
    const int G = gridDim.x, bx = blockIdx.x;
    unsigned char* ws = a.ws;
    float* stat = (float*)(ws + WS_STAT);
    bf16_t* XB = (bf16_t*)(ws + WS_XB); bf16_t* XL = (bf16_t*)(ws + WS_XL); (void)XL;
    bf16_t* BIG = (bf16_t*)(ws + WS_BIG);
    bf16_t* Qb = BIG; bf16_t* Kb = BIG + (size_t)M * D; bf16_t* Ob = BIG + 2 * (size_t)M * D; bf16_t* VT = BIG + 3 * (size_t)M * D;
    bf16_t* UY = BIG; bf16_t* VT2 = BIG + (size_t)M * SF; bf16_t* Hb = BIG;
    (void)Qb; (void)Kb; (void)VT; (void)Ob; (void)UY; (void)VT2; (void)Hb;
        const int j = i >> 1;
        const float* stat_in = stat + (size_t)(2 * i) * STAT_ELEMS; float* stat_mid = stat + (size_t)(2 * i + 1) * STAT_ELEMS; float* stat_out = stat + (size_t)(2 * i + 2) * STAT_ELEMS;
        if constexpr (PAR == 0) {
            const bf16_t* Wqkv = (const bf16_t*)(ws + WS_WQKV) + (size_t)j * 3 * D * D;
            { pg8::Gemm g{XB, Wqkv, M, 2 * D, D}; pg8::StaticOrder S; S.init(M, 2 * D, G, bx);
              pg8::EpiRow<0, true> E{Qb, D, stat_in, 1.f / D, D, (size_t)M * D, QSCALE};
              pg8::gemm_phase<pg8::EpiRow<0, true>, pg8::StaticOrder, PG_ALIGN, PG_SP2>(lds, g, S, E);

            }
            { pg8::Gemm g{Wqkv + (size_t)2 * D * D, XB, D, M, D}; pg8::StaticOrder S; S.init(D, M, G, bx);
              pg8::EpiCol<0, false, true> E{VT, PV, stat_in, 1.f / D, nullptr};
              pg8::gemm_phase<pg8::EpiCol<0, false, true>, pg8::StaticOrder, PG_ALIGN, PG_SP2>(lds, g, S, E);

            }
            grid.sync(); STAMP(1 + 5 * i + 0);
#ifndef NO_ATT
            attn_phase(Qb, Kb, VT, Ob);
#ifdef PROBE_ATT2
            attn_phase(Qb, Kb, VT, Ob);
#endif
#endif
            grid.sync(); STAMP(1 + 5 * i + 1);
            { pg8::Gemm g{Ob, (const bf16_t*)(ws + WS_WO) + (size_t)j * D * D, M, D, D}; pg8::StaticOrder S; S.init(M, D, G, bx);
              pg8::EpiRes E{XB, XL, stat_mid, D};
              pg8::gemm_phase<pg8::EpiRes, pg8::StaticOrder, PG_ALIGN, PG_SP2>(lds, g, S, E);
#ifdef PROBE_WO
              if (i == 0) pg8::gemm_phase<pg8::EpiRes, pg8::StaticOrder, PG_ALIGN, PG_SP2>(lds, g, S, E);
#endif
            }
            grid.sync(); STAMP(1 + 5 * i + 2);
        } else {
            const bf16_t* Win = (const bf16_t*)(ws + WS_WIN) + (size_t)j * 2 * SF * D;
            float* vstat = stat + (size_t)(9 + j) * STAT_ELEMS;
            { pg8::Gemm g{XB, Win, M, SF, D}; pg8::StaticOrder S; S.init(M, SF, G, bx);
              pg8::EpiRow<2> E{UY, SF, stat_in, 1.f / D, 0, 0, 1.f};
              pg8::gemm_phase<pg8::EpiRow<2>, pg8::StaticOrder, PG_ALIGN, PG_SP2>(lds, g, S, E);
#ifdef PROBE_GC
              pg8::gemm_phase<pg8::EpiRow<2>, pg8::StaticOrder, PG_ALIGN, PG_SP2>(lds, g, S, E);
#endif
            }
            { pg8::Gemm g{Win + (size_t)SF * D, XB, SF, M, D}; pg8::StaticOrder S; S.init(SF, M, G, bx);
              pg8::EpiCol<2, true> E{VT2, PV, stat_in, 1.f / D, vstat};
              pg8::gemm_phase<pg8::EpiCol<2, true>, pg8::StaticOrder, PG_ALIGN, PG_SP2>(lds, g, S, E);
#ifdef PROBE_GD
              pg8::gemm_phase<pg8::EpiCol<2, true>, pg8::StaticOrder, PG_ALIGN, PG_SP2>(lds, g, S, E);
#endif
            }
            grid.sync(); STAMP(1 + 5 * i + 0);
#ifndef NO_MIX
#ifdef PROBE_MIX2
            sgu_mix_phase<false>(lds, a.in[7] + (size_t)j * SG * SC * SC, a.in[8] + (size_t)j * SG * SC, a.in[6] + (size_t)j * SF, vstat, VT2, UY);
#endif
            sgu_mix_phase<true>(lds, a.in[7] + (size_t)j * SG * SC * SC, a.in[8] + (size_t)j * SG * SC, a.in[6] + (size_t)j * SF, vstat, VT2, UY);
#endif
            grid.sync(); STAMP(1 + 5 * i + 1);
            { pg8::Gemm g{UY, (const bf16_t*)(ws + WS_WOUT) + (size_t)j * D * SF, M, D, SF}; pg8::StaticOrder S; S.init(M, D, G, bx);
              pg8::EpiRes E{XB, XL, stat_mid, D};
              pg8::gemm_phase<pg8::EpiRes, pg8::StaticOrder, PG_ALIGN, PG_SP2>(lds, g, S, E); }
            grid.sync(); STAMP(1 + 5 * i + 2);
        }
#ifdef VAR_W1
        if (i == 0) { grid.sync(); tprev = __builtin_amdgcn_s_memrealtime();
#ifdef VAR_STAG
          if ((bx >> 3) & 3) { const unsigned long long t0_ = __builtin_amdgcn_s_memrealtime(); while (__builtin_amdgcn_s_memrealtime() - t0_ < (unsigned long long)(VAR_STAG * ((bx >> 3) & 3))) __builtin_amdgcn_s_sleep(8); }
#endif
          { pg8::Gemm g{XB, (const bf16_t*)(ws + WS_W1) + (size_t)i * FF * D, M, FF, D}; pg8::StaticOrder S; S.init(M, FF, G, bx);
            pg8::EpiVar<VAR_W1> E{Hb, FF, stat_mid, 1.f / D};
            pg8::gemm_phase<pg8::EpiVar<VAR_W1>, pg8::StaticOrder, PG_ALIGN, PG_SP2>(lds, g, S, E); }
          grid.sync(); STAMP(30); }
#endif
#ifdef STAGGER_W1
        if (bx & 8) { const unsigned long long t0_ = __builtin_amdgcn_s_memrealtime(); while (__builtin_amdgcn_s_memrealtime() - t0_ < (unsigned long long)STAGGER_W1) __builtin_amdgcn_s_sleep(8); }
#endif
        { pg8::Gemm g{XB, (const bf16_t*)(ws + WS_W1) + (size_t)i * FF * D, M, FF, D}; pg8::StaticOrder S; S.init(M, FF, G, bx);
          pg8::EpiRow<1> E{Hb, FF, stat_mid, 1.f / D, 0, 0, 1.f};
          pg8::gemm_phase<pg8::EpiRow<1>, pg8::StaticOrder, PG_ALIGN, PG_SP2>(lds, g, S, E);
#ifdef PROBE_W12
          pg8::gemm_phase<pg8::EpiRow<1>, pg8::StaticOrder, PG_ALIGN, PG_SP2>(lds, g, S, E);
#endif
        }
        grid.sync(); STAMP(1 + 5 * i + 3);
#ifdef PROBE_W2
        { pg8::Gemm g{Hb, (const bf16_t*)(ws + WS_W2) + (size_t)i * D * FF, M, D, FF}; pg8::StaticOrder S; S.init(M, D, G, bx);
          pg8::EpiRow<0> E{XB, D, stat_mid, 1.f / D, 0, 0, 1.f};
          pg8::gemm_phase<pg8::EpiRow<0>, pg8::StaticOrder, PG_ALIGN, PG_SP2>(lds, g, S, E); }
#endif
        { pg8::Gemm g{Hb, (const bf16_t*)(ws + WS_W2) + (size_t)i * D * FF, M, D, FF}; pg8::StaticOrder S; S.init(M, D, G, bx);
          pg8::EpiRes E{XB, XL, stat_out, D};
          pg8::gemm_phase<pg8::EpiRes, pg8::StaticOrder, PG_ALIGN, PG_SP2>(lds, g, S, E); }
        grid.sync(); STAMP(1 + 5 * i + 4);

}

__global__ void __launch_bounds__(512, 2) fwd_megakernel(Args a) {
    extern __shared__ __attribute__((aligned(16))) unsigned char lds_raw[];
    cg::grid_group grid = cg::this_grid();
    LAS unsigned char* lds = (LAS unsigned char*)lds_raw;
    unsigned* barw = (unsigned*)(a.ws + WS_END + 4096);
    if (blockIdx.x == 0) for (int w = threadIdx.x; w < XCD_BAR_WORDS; w += 512) barw[w] = 0u;
    volatile LAS unsigned* bst = (volatile LAS unsigned*)(lds + 131072 + 64);
    if (threadIdx.x == 0) { bst[0] = 0u; bst[1] = 0u; }
    __threadfence(); __syncthreads();
    const int G = gridDim.x, bx = blockIdx.x;
    unsigned char* ws = a.ws;
    float* stat = (float*)(ws + WS_STAT);
    bf16_t* XB = (bf16_t*)(ws + WS_XB); bf16_t* XL = (bf16_t*)(ws + WS_XL); (void)XL;
    bf16_t* BIG = (bf16_t*)(ws + WS_BIG);
    bf16_t* Qb = BIG; bf16_t* Kb = BIG + (size_t)M * D; bf16_t* Ob = BIG + 2 * (size_t)M * D; bf16_t* VT = BIG + 3 * (size_t)M * D;
    bf16_t* UY = BIG; bf16_t* VT2 = BIG + (size_t)M * SF; bf16_t* Hb = BIG;

#ifdef TSEL
    const unsigned long long t_begin = __builtin_amdgcn_s_memrealtime();
#endif
#ifndef NO_P0
    p0_prologue(a, lds);
#ifdef PROBE_P02
    __syncthreads(); p0_prologue(a, lds);
#endif
#endif
    grid.sync();
    FastSync fsync; fsync.b = xcd_barrier_post(barw, bst);
    unsigned long long tprev = 0ull, tsum = 0ull;
#ifdef TSEL
    tprev = t_begin; STAMP(0);
#endif

#ifdef LAYER_LOOP
#pragma unroll 1
    for (int jj = 0; jj < DEPTH; jj += 2) { layer_fwd<0>(a, fsync, lds, jj, tprev, tsum); layer_fwd<1>(a, fsync, lds, jj + 1, tprev, tsum); }
#else
    layer_fwd<0>(a, fsync, lds, 0, tprev, tsum); layer_fwd<1>(a, fsync, lds, 1, tprev, tsum); layer_fwd<0>(a, fsync, lds, 2, tprev, tsum); layer_fwd<1>(a, fsync, lds, 3, tprev, tsum);
#endif
#ifdef TSEL
    float tdelta = 0.f;
    { unsigned long long* tw = (unsigned long long*)(ws + WS_END);
      if (blockIdx.x == 0 && threadIdx.x == 0) { *tw = tsum; __threadfence(); }
      grid.sync();
      tdelta = (float)(*(volatile unsigned long long*)tw) * 1e-7f; tprev = __builtin_amdgcn_s_memrealtime(); }
#ifdef TCAL
    tdelta = TCAL;
#endif
#endif
#ifdef NT2
#define FINLD(p) __builtin_nontemporal_load(p)
#else
#define FINLD(p) (*(p))
#endif
    { OPAQUE_IDS(); const float* st = stat + (size_t)8 * STAT_ELEMS; const f32x4* gn = (const f32x4*)a.in[12] + lane; const int gw = vcu * 8 + wave, NGW = G * 8;
      const bf16_t* XBf = (const bf16_t*)(ws + WS_XB); const bf16_t* XLf = (const bf16_t*)(ws + WS_XL);
      f32x4 gv[4];
#pragma unroll
      for (int jj = 0; jj < 4; ++jj) gv[jj] = gn[64 * jj];
      for (int m0 = gw; m0 < M; m0 += 4 * NGW) {
          u32x2 hw[4][4], lw[4][4]; float sp[4];
#pragma unroll
          for (int q = 0; q < 4; ++q) { const int m = (m0 + q * NGW < M) ? m0 + q * NGW : m0; const u32x2* h8 = (const u32x2*)(XBf + (size_t)m * D) + lane; const u32x2* l8 = (const u32x2*)(XLf + (size_t)m * D) + lane;
              sp[q] = lane < 16 ? st[(size_t)m * 16 + lane] : 0.f;
#pragma unroll
              for (int jj = 0; jj < 4; ++jj) { hw[q][jj] = FINLD(&h8[64 * jj]); lw[q][jj] = RES_LO ? FINLD(&l8[64 * jj]) : (u32x2){0u, 0u}; } }
#pragma unroll
          for (int q = 0; q < 4; ++q) { const int m = m0 + q * NGW; if (m >= M) break; f32x4* xr = (f32x4*)(a.out + (size_t)m * D) + lane;
              const float rs = __builtin_amdgcn_rsqf(wave_sum(sp[q]) * (1.f / D) + EPS);
#pragma unroll
              for (int jj = 0; jj < 4; ++jj) { const u32x2 h2 = hw[q][jj], l2 = lw[q][jj]; f32x4 v;
                  v.x = __uint_as_float(h2.x << 16) + __uint_as_float(l2.x << 16); v.y = __uint_as_float(h2.x & 0xffff0000u) + __uint_as_float(l2.x & 0xffff0000u);
                  v.z = __uint_as_float(h2.y << 16) + __uint_as_float(l2.y << 16); v.w = __uint_as_float(h2.y & 0xffff0000u) + __uint_as_float(l2.y & 0xffff0000u);
                  v = v * rs * gv[jj];
#if defined(TSEL) && !defined(TFINAL)
                  if (jj == 0 && lane < 4) v = v + tdelta;
#endif
                  __builtin_nontemporal_store(v, &xr[64 * jj]); } } }
      }
#ifdef PROBE_REP
    fsync.sync(); p0_prologue(a, lds); fsync.sync();
    layer_fwd<0>(a, fsync, lds, 0, tprev, tsum); layer_fwd<1>(a, fsync, lds, 1, tprev, tsum); layer_fwd<0>(a, fsync, lds, 2, tprev, tsum); layer_fwd<1>(a, fsync, lds, 3, tprev, tsum);
    { OPAQUE_IDS(); const float* st = stat + (size_t)8 * STAT_ELEMS; const f32x4* gn = (const f32x4*)a.in[12] + lane; const int gw = vcu * 8 + wave, NGW = G * 8;
      const bf16_t* XBf = (const bf16_t*)(ws + WS_XB); const bf16_t* XLf = (const bf16_t*)(ws + WS_XL);
      f32x4 gv[4];
#pragma unroll
      for (int jj = 0; jj < 4; ++jj) gv[jj] = gn[64 * jj];
      for (int m = gw; m < M; m += NGW) { f32x4* xr = (f32x4*)(a.out + (size_t)m * D) + lane; const u32x2* h8 = (const u32x2*)(XBf + (size_t)m * D) + lane; const u32x2* l8 = (const u32x2*)(XLf + (size_t)m * D) + lane;
          const float rs = __builtin_amdgcn_rsqf(wave_sum(lane < 16 ? st[(size_t)m * 16 + lane] : 0.f) * (1.f / D) + EPS);
#pragma unroll
          for (int jj = 0; jj < 4; ++jj) { const u32x2 hw = FINLD(&h8[64 * jj]), lw = RES_LO ? FINLD(&l8[64 * jj]) : (u32x2){0u, 0u}; f32x4 v;
              v.x = __uint_as_float(hw.x << 16) + __uint_as_float(lw.x << 16); v.y = __uint_as_float(hw.x & 0xffff0000u) + __uint_as_float(lw.x & 0xffff0000u);
              v.z = __uint_as_float(hw.y << 16) + __uint_as_float(lw.y << 16); v.w = __uint_as_float(hw.y & 0xffff0000u) + __uint_as_float(lw.y & 0xffff0000u);
              v = v * rs * gv[jj];
#if defined(TSEL) && !defined(TFINAL)
              if (jj == 0 && lane < 4) v = v + tdelta;
#endif
#if 1
              __builtin_nontemporal_store(v, &xr[64 * jj]);
#else
              xr[64 * jj] = v;
#endif
          } } }
#endif
#ifdef TFINAL
    { unsigned long long* tw = (unsigned long long*)(ws + WS_END) + 8;
      grid.sync();
      const unsigned long long tn = __builtin_amdgcn_s_memrealtime();
      if (blockIdx.x == 0 && threadIdx.x == 0) { *tw = tn - tprev; __threadfence(); }
      grid.sync();
      const float td = (float)(*(volatile unsigned long long*)tw) * 1e-7f;
      OPAQUE_IDS(); const int gw = vcu * 8 + wave, NGW = G * 8;
      for (int m = gw; m < M; m += NGW) { if (lane < 4) { f32x4* xr = (f32x4*)(a.out + (size_t)m * D) + lane; xr[0] = xr[0] + td; } } }
#endif
}

extern "C" void kernel_launch(void* const* d_in, const int* in_sizes, int n_in, void* d_out, int out_size, void* d_ws, size_t ws_size, hipStream_t stream) {
    static int grid = 0;
    if (grid == 0) {
        if (n_in != 13 || in_sizes[0] != M * D || out_size != M * D || ws_size < WS_END) { fprintf(stderr, "kernel_launch: unexpected shapes (n_in %d, in0 %d, out %d, ws %zu)\n", n_in, n_in > 0 ? in_sizes[0] : -1, out_size, ws_size); grid = -1; return; }
        int dev = 0, cus = 0, per_cu = 0;
        if (hipGetDevice(&dev) != hipSuccess || hipDeviceGetAttribute(&cus, hipDeviceAttributeMultiprocessorCount, dev) != hipSuccess) { grid = -1; return; }
        if (hipFuncSetAttribute((const void*)fwd_megakernel, hipFuncAttributeMaxDynamicSharedMemorySize, LDS_BYTES) != hipSuccess) { fprintf(stderr, "kernel_launch: hipFuncSetAttribute failed\n"); grid = -1; return; }
        if (hipOccupancyMaxActiveBlocksPerMultiprocessor(&per_cu, (const void*)fwd_megakernel, 512, LDS_BYTES) != hipSuccess || per_cu < 1) { fprintf(stderr, "kernel_launch: occupancy query says %d\n", per_cu); per_cu = 1; }
        (void)hipGetLastError();
        grid = cus;
    }
    if (grid < 0) return;
    Args a{};
    for (int i = 0; i < 13; ++i) a.in[i] = (const float*)d_in[i];
    a.out = (float*)d_out; a.ws = (unsigned char*)d_ws;
    void* args[] = {&a};
    hipError_t e = hipLaunchCooperativeKernel((const void*)fwd_megakernel, dim3(grid), dim3(512), args, LDS_BYTES, stream);
    if (e != hipSuccess) fprintf(stderr, "kernel_launch: cooperative launch failed: %s (grid %d)\n", hipGetErrorString(e), grid);
}
```

```cpp
#include <hip/hip_runtime.h>
#include <hip/hip_cooperative_groups.h>
#include <cstdio>
#include <cstdint>
namespace cg = cooperative_groups;
#ifndef PG_WGM
#define PG_WGM 8
#endif
namespace pg8 {
#define PG8_LAS __attribute__((address_space(3)))
typedef unsigned short bf16_t;
typedef short bf16x8 __attribute__((ext_vector_type(8)));
typedef float f32x4 __attribute__((ext_vector_type(4)));
typedef unsigned u32x4 __attribute__((ext_vector_type(4)));
constexpr int BM = 256, BK = 64, HALF = 128, HTB = HALF * BK * 2  , STAGE_BYTES = 8 * HTB, NXCD = 8, WGM = PG_WGM;

__host__ __device__ __forceinline__ int lds_byte(int r, int c) { const int st = (r >> 4) * 2 + (c >> 5), rr = r & 15, cc = c & 31, ob = rr * 64 + cc * 2; return st * 1024 + (ob ^ (((ob >> 9) & 1) << 5)); }
__host__ __device__ __forceinline__ void stage_rc(int b, int& R, int& C) { const int st = b / 1024, sb = b % 1024, swz = sb ^ (((sb >> 9) & 1) << 5); R = (st >> 1) * 16 + swz / 64; C = (st & 1) * 32 + (swz % 64) / 2; }
__host__ __device__ __forceinline__ int perm32(int rho) { const int n = rho >> 4, i = rho & 15; return 8 * (i >> 2) + 4 * n + (i & 3); }

struct Unit { int pm, pn; };
struct Gemm { const bf16_t* A; const bf16_t* Bt; int M, N, K; };

struct StaticOrder {
    int nM, nN, nwg, G, c;
    __host__ __device__ void init(int M, int N, int G_, int c_) { nM = M / BM; nN = N / BM; nwg = nM * nN; G = G_; c = c_; }
    __host__ __device__ bool next(int i, Unit& u) const {
        const long L = (long)i * G + c; if (L >= nwg) return false;
        int wgid = (int)L; { const int q = nwg / NXCD, r = nwg % NXCD, xcd = wgid % NXCD, off = wgid / NXCD; wgid = (xcd < r ? xcd * (q + 1) : r * (q + 1) + (xcd - r) * q) + off; }
        const int nig = WGM * nN, gid = wgid / nig, fm = gid * WGM, gsz = (nM - fm) < WGM ? (nM - fm) : WGM;
        u.pm = fm + ((wgid % nig) % gsz); u.pn = (wgid % nig) / gsz; return true;
    }
    __device__ __forceinline__ void a_ready(const Unit&) const {}
    __device__ __forceinline__ void done(const Unit&) const {}
};

typedef float f32x2_t __attribute__((ext_vector_type(2))); typedef __bf16 bf16x2_t __attribute__((ext_vector_type(2))); typedef unsigned u32x2 __attribute__((ext_vector_type(2)));
__device__ __forceinline__ unsigned pk2(float lo, float hi) { f32x2_t v = {lo, hi}; bf16x2_t b = __builtin_convertvector(v, bf16x2_t); return __builtin_bit_cast(unsigned, b); }
constexpr float NORM_EPS = 1e-6f;
#ifndef RELAX_DEFAULT
#define RELAX_DEFAULT false
#endif
#if 1
#define ST16(p, v) __builtin_nontemporal_store((v), (u32x4*)(p))
#define ST8(p, v) __builtin_nontemporal_store((v), (u32x2*)(p))
#else
#define ST16(p, v) (*(u32x4*)(p) = (v))
#define ST8(p, v) (*(u32x2*)(p) = (v))
#endif
#if 1
#define ST16L(p, v) __builtin_nontemporal_store((v), (u32x4*)(p))
#else
#define ST16L(p, v) ST16R(p, v)
#endif
#ifdef NT_RESLD
#define LD16R(p) __builtin_nontemporal_load((const u32x4*)(p))
#else
#define LD16R(p) (*(const u32x4*)(p))
#endif
#ifdef NT_RES
#define ST16R(p, v) __builtin_nontemporal_store((v), (u32x4*)(p))
#else
#define ST16R(p, v) (*(u32x4*)(p) = (v))
#endif
template <int ACT> __device__ __forceinline__ float act_fn(float x) {
    if (ACT == 1) { const float v = fmaxf(x, 0.f); return v * v; }
    if (ACT == 2) { const float e = __builtin_amdgcn_exp2f(-2.302208198f * x * (1.f + 0.044715f * x * x)); return x * __builtin_amdgcn_rcpf(1.f + e); }
    return x;
}
template <int ACT, bool TILED = false> struct EpiRow {
    static constexpr bool PERM = true, AFTER_DRAIN = false, RELAX_OK = RELAX_DEFAULT;
    bf16_t* O; int ldc; const float* stat; float inv_n; int split_cols; size_t split_stride; float scale0;
    template <class Sched> __device__ __forceinline__ void prepare(PG8_LAS float* tab, const Sched& S, int tid) const {
        Unit u;
#pragma unroll 4
        for (int ui = 0; S.next(ui, u); ++ui) { const f32x4* sp = (const f32x4*)(stat + (size_t)(u.pm * BM + (tid >> 1)) * 16 + (tid & 1) * 8); const f32x4 q = sp[0] + sp[1];
            float s = (q[0] + q[1]) + (q[2] + q[3]); s += __shfl_xor(s, 1); if (!(tid & 1)) tab[ui * 256 + (tid >> 1)] = __builtin_amdgcn_rsqf(s * inv_n + NORM_EPS); }
    }
    __device__ __forceinline__ void operator()(const f32x4 (&acc)[2][2][4][2], const Unit& u, int wr, int wc, int fr, int fq, int ui, const PG8_LAS float* tab) const {
        const int row0 = u.pm * BM + wr * 64 + fr; int colt = u.pn * BM; bf16_t* base = O; float sc = 1.f;
        if (split_cols) { const int t = colt / split_cols; base += (size_t)t * split_stride; colt -= t * split_cols; if (t == 0) sc = scale0; }
        const int col0 = colt + wc * 32 + 8 * fq;
#pragma unroll
        for (int ai = 0; ai < 2; ++ai)
#pragma unroll
            for (int m = 0; m < 4; ++m) { const int row = row0 + ai * HALF + m * 16; const float rs = tab[ui * 256 + ai * HALF + wr * 64 + m * 16 + fr];
                bf16_t* rowp = base + (size_t)row * ldc + col0;
#pragma unroll
                for (int bj = 0; bj < 2; ++bj) { f32x4 v0 = acc[ai][bj][m][0] * rs, v1 = acc[ai][bj][m][1] * rs;
#pragma unroll
                    for (int e = 0; e < 4; ++e) { v0[e] = act_fn<ACT>(v0[e]) * sc; v1[e] = act_fn<ACT>(v1[e]) * sc; }
                    u32x4 w; w.x = pk2(v0[0], v0[1]); w.y = pk2(v0[2], v0[3]); w.z = pk2(v1[0], v1[1]); w.w = pk2(v1[2], v1[3]);
                    if (TILED) { const int c = col0 + bj * HALF, hd = c >> 6, d = c & 63, b = row >> 11, sq = row & 2047, kt = sq >> 5, r = sq & 31;
                        ST16(base + ((size_t)(((b * 16 + hd) * 64 + kt)) << 11) + (d >> 4) * 512 + (((d >> 3) & 1) * 32 + r) * 8, w); }
                    else ST16(rowp + bj * HALF, w); } }
    }
};
template <int V> struct EpiVar {
    static constexpr bool PERM = true, AFTER_DRAIN = false, RELAX_OK = false;
    bf16_t* O; int ldc; const float* stat; float inv_n;
    template <class Sched> __device__ __forceinline__ void prepare(PG8_LAS float*, const Sched&, int) const {}
    __device__ __forceinline__ void operator()(const f32x4 (&acc)[2][2][4][2], const Unit& u, int wr, int wc, int fr, int fq, int ui, const PG8_LAS float* tab) const {
        if (V == 3) return;
        const int row0 = u.pm * BM + wr * 64 + fr; const int col0 = u.pn * BM + wc * 32 + 8 * fq;
#pragma unroll
        for (int ai = 0; ai < 2; ++ai)
#pragma unroll
            for (int m = 0; m < 4; ++m) { const int row = row0 + ai * HALF + m * 16; float rs = 1.f;
                if (V != 1) { const f32x4 p4 = *(const f32x4*)(stat + (size_t)row * 16 + 4 * fq); float s = (p4[0] + p4[1]) + (p4[2] + p4[3]); s += __shfl_xor(s, 16); s += __shfl_xor(s, 32); rs = __builtin_amdgcn_rsqf(s * inv_n + NORM_EPS); }
                bf16_t* rowp = O + (size_t)row * ldc + col0;
#pragma unroll
                for (int bj = 0; bj < 2; ++bj) { f32x4 v0 = acc[ai][bj][m][0] * rs, v1 = acc[ai][bj][m][1] * rs;
#pragma unroll
                    for (int e = 0; e < 4; ++e) { v0[e] = act_fn<1>(v0[e]); v1[e] = act_fn<1>(v1[e]); }
                    u32x4 w; w.x = pk2(v0[0], v0[1]); w.y = pk2(v0[2], v0[3]); w.z = pk2(v1[0], v1[1]); w.w = pk2(v1[2], v1[3]);
                    if (V != 2 || w.x == 0x7fc17fc1u) *(u32x4*)(rowp + bj * HALF) = w; } }
    }
};
template <int ACT, bool VSTAT, bool TILED = false> struct EpiCol {
    static constexpr bool PERM = true, AFTER_DRAIN = false, RELAX_OK = RELAX_DEFAULT;
    bf16_t* O; size_t ldc; const float* stat; float inv_n; float* vstat;
    template <class Sched> __device__ __forceinline__ void prepare(PG8_LAS float* tab, const Sched& S, int tid) const {
        Unit u;
#pragma unroll 4
        for (int ui = 0; S.next(ui, u); ++ui) { const f32x4* sp = (const f32x4*)(stat + (size_t)(u.pn * BM + (tid >> 1)) * 16 + (tid & 1) * 8); const f32x4 q = sp[0] + sp[1];
            float s = (q[0] + q[1]) + (q[2] + q[3]); s += __shfl_xor(s, 1); if (!(tid & 1)) tab[ui * 256 + (tid >> 1)] = __builtin_amdgcn_rsqf(s * inv_n + NORM_EPS); }
    }
    __device__ __forceinline__ void operator()(const f32x4 (&acc)[2][2][4][2], const Unit& u, int wr, int wc, int fr, int fq, int ui, const PG8_LAS float* tab) const {
        const int row0 = u.pm * BM + wr * 64 + fr; const int col0 = u.pn * BM + wc * 32 + 8 * fq;
        f32x4 rsv[2][2], sq[2][2];
#pragma unroll
        for (int bj = 0; bj < 2; ++bj)
#pragma unroll
            for (int n = 0; n < 2; ++n) { rsv[bj][n] = *(const PG8_LAS f32x4*)(tab + ui * 256 + wc * 32 + 8 * fq + bj * HALF + 4 * n); sq[bj][n] = (f32x4){0.f, 0.f, 0.f, 0.f}; }
#pragma unroll
        for (int ai = 0; ai < 2; ++ai)
#pragma unroll
            for (int m = 0; m < 4; ++m) { bf16_t* rowp = O + (size_t)(row0 + ai * HALF + m * 16) * ldc + col0;
#pragma unroll
                for (int bj = 0; bj < 2; ++bj) { f32x4 v0 = acc[ai][bj][m][0] * rsv[bj][0], v1 = acc[ai][bj][m][1] * rsv[bj][1];
#pragma unroll
                    for (int e = 0; e < 4; ++e) { v0[e] = act_fn<ACT>(v0[e]); v1[e] = act_fn<ACT>(v1[e]); }
                    if (VSTAT) { sq[bj][0] += v0 * v0; sq[bj][1] += v1 * v1; }
                    u32x4 w; w.x = pk2(v0[0], v0[1]); w.y = pk2(v0[2], v0[3]); w.z = pk2(v1[0], v1[1]); w.w = pk2(v1[2], v1[3]);
                    if (TILED) { const int ch = row0 + ai * HALF + m * 16, hd = ch >> 6, d = ch & 63, tk = col0 + bj * HALF, b = tk >> 11, sq = tk & 2047, kt = sq >> 5, k0 = sq & 31;
                        bf16_t* tp = O + ((size_t)(((b * 16 + hd) * 64 + kt)) << 11) + ((((d >> 5) * 2 + (k0 >> 4)) * 2 + ((k0 >> 3) & 1)) * 256) + (d & 31) * 4;
                        u32x2 lo, hi; lo.x = w.x; lo.y = w.y; hi.x = w.z; hi.y = w.w; ST8(tp, lo); ST8(tp + 128, hi); }
                    else ST16(rowp + bj * HALF, w); } }
        if (VSTAT) {
#pragma unroll
            for (int bj = 0; bj < 2; ++bj)
#pragma unroll
                for (int n = 0; n < 2; ++n)
#pragma unroll
                    for (int e = 0; e < 4; ++e) { float s = sq[bj][n][e]; s += __shfl_xor(s, 1); s += __shfl_xor(s, 2); s += __shfl_xor(s, 4); s += __shfl_xor(s, 8);
                        if (fr == bj * 8 + n * 4 + e) vstat[(size_t)(col0 + bj * HALF + 4 * n + e) * 16 + u.pm * 2 + wr] = s; }
        }
    }
};
#ifndef RES_LO
#define RES_LO 0
#endif
struct EpiRes {
    static constexpr bool PERM = true, AFTER_DRAIN = false, RELAX_OK = RELAX_DEFAULT;
    bf16_t* xb; bf16_t* xl; float* stat; int ldc;
    template <class Sched> __device__ __forceinline__ void prepare(PG8_LAS float*, const Sched&, int) const {}
    __device__ __forceinline__ void operator()(const f32x4 (&acc)[2][2][4][2], const Unit& u, int wr, int wc, int fr, int fq, int ui, const PG8_LAS float* tab) const {
        const int row0 = u.pm * BM + wr * 64 + fr; const int col0 = u.pn * BM + wc * 32 + 8 * fq;
#pragma unroll
        for (int ai = 0; ai < 2; ++ai) {
            u32x4 bh[4][2], bl[4][2];
#pragma unroll
            for (int m = 0; m < 4; ++m) { const size_t off = (size_t)(row0 + ai * HALF + m * 16) * ldc + col0;
#pragma unroll
                for (int bj = 0; bj < 2; ++bj) { bh[m][bj] = LD16R(xb + off + bj * HALF); bl[m][bj] = RES_LO ? LD16R(xl + off + bj * HALF) : (u32x4){0u, 0u, 0u, 0u}; } }
#pragma unroll
            for (int m = 0; m < 4; ++m) { const int row = row0 + ai * HALF + m * 16; const size_t off = (size_t)row * ldc + col0; float ss = 0.f;
#pragma unroll
                for (int bj = 0; bj < 2; ++bj) { const u32x4 h4 = bh[m][bj], l4 = bl[m][bj]; u32x4 wh, wl;
#pragma unroll
                    for (int e = 0; e < 4; ++e) { const int n = e >> 1, k = (e & 1) * 2;
                        const float x0 = __uint_as_float(h4[e] << 16) + __uint_as_float(l4[e] << 16) + acc[ai][bj][m][n][k];
                        const float x1 = __uint_as_float(h4[e] & 0xffff0000u) + __uint_as_float(l4[e] & 0xffff0000u) + acc[ai][bj][m][n][k + 1];
                        ss += x0 * x0 + x1 * x1;
                        const unsigned hw = pk2(x0, x1); wh[e] = hw;
                        wl[e] = pk2(x0 - __uint_as_float(hw << 16), x1 - __uint_as_float(hw & 0xffff0000u)); }
                    ST16R(xb + off + bj * HALF, wh); if (RES_LO) ST16L(xl + off + bj * HALF, wl); }
                ss += __shfl_xor(ss, 16); ss += __shfl_xor(ss, 32);
                if (fq == 0) stat[(size_t)row * 16 + u.pn * 4 + wc] = ss; }
        }
    }
};

template <class Epi, class Sched, bool ALIGN_EPI = false, bool SP2 = false>
__device__ __forceinline__ void gemm_phase(PG8_LAS unsigned char* lds, const Gemm g, const Sched& S0, const Epi& E) {
    PG8_LAS float* tab = (PG8_LAS float*)(lds + STAGE_BYTES + 1024);
    Sched S = S0; asm volatile("" : "+s"(S.c));
    int tid_ = threadIdx.x, K_ = g.K; asm volatile("" : "+v"(tid_), "+s"(K_));
    const int tid = tid_, wid = __builtin_amdgcn_readfirstlane(tid >> 6), lane = tid & 63, wr = wid >> 2, wc = wid & 3, fr = lane & 15, fq = lane >> 4;
    const int K = K_, nt = K / BK;
    unsigned voffA[2], voffB[2];
#pragma unroll
    for (int i = 0; i < 2; ++i) { int R, C; stage_rc(tid * 16 + i * 8192, R, C); const int Rb = Epi::PERM ? ((R & ~31) + perm32(R & 31)) : R;
        voffA[i] = (unsigned)(R * K + C) * 2u; voffB[i] = (unsigned)(Rb * K + C) * 2u; }
    const size_t kstep = (size_t)(BK * 2);
    const size_t hstep = (size_t)HALF * K * 2;
    const size_t tstep = 2 * hstep;
    const unsigned ldsw = (unsigned)wid * 1024u;
    const int aoff = lds_byte(wr * 64 + fr, fq * 8), boff = lds_byte(wc * 32 + fr, fq * 8);
#define PG8_SA(b, h) (((b) * 2 + (h)) * HTB)
#define PG8_SB(b, h) ((4 + (b) * 2 + (h)) * HTB)
#define PG8_STAGE(bufoff, gbase, voff) do { _Pragma("unroll") for (int _i = 0; _i < 2; ++_i) \
        __builtin_amdgcn_global_load_lds((const unsigned*)((const char*)(gbase) + (voff)[_i]), (PG8_LAS unsigned*)(lds + (bufoff) + ldsw + _i * 8192), 16, 0, 0); } while (0)
#define PG8_LDA(dst, b, h) do { _Pragma("unroll") for (int m = 0; m < 4; ++m) _Pragma("unroll") for (int k = 0; k < 2; ++k) dst[m][k] = *(const PG8_LAS bf16x8*)(lds + PG8_SA(b, h) + aoff + m * 2048 + k * 1024); } while (0)
#define PG8_LDB(dst, b, h) do { _Pragma("unroll") for (int n = 0; n < 2; ++n) _Pragma("unroll") for (int k = 0; k < 2; ++k) dst[n][k] = *(const PG8_LAS bf16x8*)(lds + PG8_SB(b, h) + boff + n * 2048 + k * 1024); } while (0)
#define PG8_MMA(ai, bj, At, Bt) do { __builtin_amdgcn_s_setprio(1); _Pragma("unroll") for (int m = 0; m < 4; ++m) _Pragma("unroll") for (int n = 0; n < 2; ++n) _Pragma("unroll") for (int k = 0; k < 2; ++k) \
        acc[ai][bj][m][n] = __builtin_amdgcn_mfma_f32_16x16x32_bf16(Bt[n][k], At[m][k], acc[ai][bj][m][n], 0, 0, 0); __builtin_amdgcn_s_setprio(0); } while (0)
#define PG8_WAIT_V(n) asm volatile("s_waitcnt vmcnt(" #n ")" ::: "memory")
#define PG8_WAIT_L(n) asm volatile("s_waitcnt lgkmcnt(" #n ")" ::: "memory")
#define PG8_BAR __builtin_amdgcn_s_barrier()
#define PG8_SCHED __builtin_amdgcn_sched_barrier(0)
    Unit cur, nxt; int ui = 0;
    if (!S.next(0, cur)) return;
    E.prepare(tab, S, tid); __syncthreads();
    f32x4 acc[2][2][4][2];
#pragma unroll
    for (int a = 0; a < 2; ++a)
#pragma unroll
        for (int b = 0; b < 2; ++b)
#pragma unroll
            for (int m = 0; m < 4; ++m)
#pragma unroll
                for (int n = 0; n < 2; ++n) acc[a][b][m][n] = (f32x4){0.f, 0.f, 0.f, 0.f};
    bf16x8 At[4][2], B0[2][2], B1[2][2];
    const char* cA = (const char*)g.A + (size_t)cur.pm * tstep; const char* cB = (const char*)g.Bt + (size_t)cur.pn * tstep;
    S.a_ready(cur);
    if constexpr (SP2) {
        PG8_STAGE(PG8_SB(0, 0), cB, voffB); PG8_STAGE(PG8_SB(0, 1), cB + hstep, voffB); PG8_STAGE(PG8_SA(0, 0), cA, voffA); PG8_STAGE(PG8_SA(0, 1), cA + hstep, voffA);
        if (wr == 1) PG8_BAR;
        PG8_WAIT_V(2); PG8_BAR;
        PG8_STAGE(PG8_SB(1, 0), cB + kstep, voffB); PG8_STAGE(PG8_SA(1, 0), cA + kstep, voffA); PG8_STAGE(PG8_SB(1, 1), cB + hstep + kstep, voffB);
        PG8_WAIT_V(6); PG8_BAR;
    } else {
        PG8_STAGE(PG8_SB(0, 0), cB, voffB); PG8_STAGE(PG8_SA(0, 0), cA, voffA); PG8_STAGE(PG8_SB(0, 1), cB + hstep, voffB); PG8_STAGE(PG8_SA(0, 1), cA + hstep, voffA);
        if (wr == 1) PG8_BAR;
        PG8_WAIT_V(4); PG8_BAR;
        PG8_STAGE(PG8_SB(1, 0), cB + kstep, voffB); PG8_STAGE(PG8_SA(1, 0), cA + kstep, voffA); PG8_STAGE(PG8_SB(1, 1), cB + hstep + kstep, voffB);
        PG8_WAIT_V(6); PG8_BAR;
    }
    for (;;) {
        const bool has_next = S.next(ui + 1, nxt);
        const char* nA = has_next ? (const char*)g.A + (size_t)nxt.pm * tstep : cA; const char* nB = has_next ? (const char*)g.Bt + (size_t)nxt.pn * tstep : cB;
        for (int t = 0; t < nt; t += 2) {
            const bool last = (t == nt - 2);
            const char* a1 = cA + (size_t)(t + 1) * kstep;
            const char* a2 = last ? nA : cA + (size_t)(t + 2) * kstep; const char* b2 = last ? nB : cB + (size_t)(t + 2) * kstep;
            const char* a3 = a2 + kstep; const char* b3 = b2 + kstep;
            if (last && has_next) S.a_ready(nxt);
            if constexpr (SP2) {
            const int relax = __builtin_amdgcn_readfirstlane((Epi::RELAX_OK && (t == 0) && (ui > 0)) ? 1 : 0);
            PG8_LDB(B0, 0, 0); PG8_LDB(B1, 0, 1); PG8_SCHED; PG8_LDA(At, 0, 0); PG8_STAGE(PG8_SA(1, 1), a1 + hstep, voffA);
            asm volatile("s_cmp_lg_u32 %0, 0\n\ts_cbranch_scc1 1\n\ts_waitcnt vmcnt(8)" :: "s"(relax) : "memory", "scc");
            PG8_WAIT_L(0); PG8_BAR; PG8_MMA(0, 0, At, B0); PG8_MMA(0, 1, At, B1); PG8_BAR; PG8_SCHED;
            PG8_LDA(At, 0, 1); PG8_STAGE(PG8_SB(0, 0), b2, voffB); PG8_STAGE(PG8_SB(0, 1), b2 + hstep, voffB); PG8_STAGE(PG8_SA(0, 0), a2, voffA);
            asm volatile("s_cmp_lg_u32 %0, 0\n\ts_cbranch_scc1 1\n\ts_waitcnt vmcnt(8)" :: "s"(relax) : "memory", "scc");
            PG8_WAIT_L(0); PG8_BAR; PG8_MMA(1, 0, At, B0); PG8_MMA(1, 1, At, B1); PG8_BAR; PG8_SCHED;
            PG8_LDB(B0, 1, 0); PG8_LDB(B1, 1, 1); PG8_SCHED; PG8_LDA(At, 1, 0); PG8_STAGE(PG8_SA(0, 1), a2 + hstep, voffA);
            PG8_WAIT_V(8); PG8_WAIT_L(0); PG8_BAR; PG8_MMA(0, 0, At, B0); PG8_MMA(0, 1, At, B1); PG8_BAR; PG8_SCHED;
            PG8_LDA(At, 1, 1); PG8_STAGE(PG8_SB(1, 0), b3, voffB); PG8_STAGE(PG8_SB(1, 1), b3 + hstep, voffB); PG8_STAGE(PG8_SA(1, 0), a3, voffA);
            PG8_WAIT_V(8); PG8_WAIT_L(0); PG8_BAR; PG8_MMA(1, 0, At, B0); PG8_MMA(1, 1, At, B1); PG8_BAR; PG8_SCHED;
            } else {
            PG8_LDB(B0, 0, 0); PG8_SCHED; PG8_LDA(At, 0, 0); PG8_STAGE(PG8_SA(1, 1), a1 + hstep, voffA);
            PG8_WAIT_L(8); PG8_BAR; PG8_WAIT_L(0); PG8_MMA(0, 0, At, B0); PG8_BAR; PG8_SCHED;
            PG8_LDB(B1, 0, 1); PG8_STAGE(PG8_SB(0, 0), b2, voffB);
            PG8_BAR; PG8_WAIT_L(0); PG8_MMA(0, 1, At, B1); PG8_BAR;
            PG8_LDA(At, 0, 1); PG8_STAGE(PG8_SA(0, 0), a2, voffA);
            PG8_BAR; PG8_WAIT_L(0); PG8_MMA(1, 0, At, B0); PG8_BAR; PG8_SCHED;
            PG8_STAGE(PG8_SB(0, 1), b2 + hstep, voffB);
            PG8_WAIT_V(6); PG8_BAR; PG8_MMA(1, 1, At, B1); PG8_BAR;
            PG8_LDB(B0, 1, 0); PG8_SCHED; PG8_LDA(At, 1, 0); PG8_STAGE(PG8_SA(0, 1), a2 + hstep, voffA);
            PG8_WAIT_L(8); PG8_BAR; PG8_WAIT_L(0); PG8_MMA(0, 0, At, B0); PG8_BAR; PG8_SCHED;
            PG8_LDB(B1, 1, 1); PG8_STAGE(PG8_SB(1, 0), b3, voffB);
            PG8_BAR; PG8_WAIT_L(0); PG8_MMA(0, 1, At, B1); PG8_BAR;
            PG8_LDA(At, 1, 1); PG8_STAGE(PG8_SA(1, 0), a3, voffA);
            PG8_BAR; PG8_WAIT_L(0); PG8_MMA(1, 0, At, B0); PG8_BAR; PG8_SCHED;
            PG8_STAGE(PG8_SB(1, 1), b3 + hstep, voffB);
            PG8_WAIT_V(6); PG8_BAR; PG8_MMA(1, 1, At, B1); PG8_BAR;
            }
        }
        if constexpr (ALIGN_EPI) { if (wr == 0) PG8_BAR; }
        if constexpr (!Epi::AFTER_DRAIN) { E(acc, cur, wr, wc, fr, fq, ui, tab); S.done(cur); }
        if (!has_next) break;
#pragma unroll
        for (int a = 0; a < 2; ++a)
#pragma unroll
            for (int b = 0; b < 2; ++b)
#pragma unroll
                for (int m = 0; m < 4; ++m)
#pragma unroll
                    for (int n = 0; n < 2; ++n) acc[a][b][m][n] = (f32x4){0.f, 0.f, 0.f, 0.f};
        cur = nxt; cA = nA; cB = nB; ++ui;
        if constexpr (ALIGN_EPI) { if (wr == 1) PG8_BAR; }
    }
    PG8_WAIT_V(0);
    if constexpr (!ALIGN_EPI) { if (wr == 0) PG8_BAR; }
    PG8_BAR;
    if constexpr (Epi::AFTER_DRAIN) { E.fused(acc, cur, wr, wc, fr, fq, lds, wid, lane); S.done(cur); }
#undef PG8_SA
#undef PG8_SB
#undef PG8_STAGE
#undef PG8_LDA
#undef PG8_LDB
#undef PG8_MMA
#undef PG8_WAIT_V
#undef PG8_WAIT_L
#undef PG8_BAR
#undef PG8_SCHED
}
}
#define LAS __attribute__((address_space(3)))
typedef unsigned short bf16_t;
typedef short bf16x8 __attribute__((ext_vector_type(8)));
typedef short s16x4 __attribute__((ext_vector_type(4)));
typedef float f32x4 __attribute__((ext_vector_type(4)));
typedef float f32x16 __attribute__((ext_vector_type(16)));
typedef unsigned u32x4 __attribute__((ext_vector_type(4)));
using pg8::u32x2;
using pg8::pk2;
#ifndef PG_ALIGN
#define PG_ALIGN true
#endif
#ifndef PG_SP2
#define PG_SP2 true
#endif
#define MFMA32(a, b, c) __builtin_amdgcn_mfma_f32_32x32x16_bf16((a), (b), (c), 0, 0, 0)
#define LDS_WAIT() asm volatile("s_waitcnt lgkmcnt(0)" ::: "memory")

constexpr int BATCH = 32, SEQ = 2048, D = 1024, M = BATCH * SEQ, DEPTH = 4, NH = 16, HD = 64, FF = 4096, SF = 2048, SG = 8, SC = 128, SGW = 256;
constexpr float EPS = 1e-6f;
constexpr float QSCALE = 0.125f * 1.4426950408889634f;
constexpr size_t MiB = 1u << 20;
constexpr size_t WS_WQKV = 4 * MiB;
constexpr size_t WS_WO = 16 * MiB;
constexpr size_t WS_WIN = 20 * MiB;
constexpr size_t WS_WOUT = 36 * MiB;
constexpr size_t WS_W1 = 44 * MiB;
constexpr size_t WS_W2 = 76 * MiB;
constexpr size_t WS_XB = 112 * MiB;
constexpr size_t WS_BIG = 240 * MiB;
constexpr size_t PV = (size_t)M + 128;
constexpr size_t WS_STAT = 756 * MiB;
constexpr size_t STAT_ELEMS = (size_t)M * 16;
constexpr size_t WS_XL = 800 * MiB;
constexpr size_t WS_END = 928 * MiB;
constexpr int LDS_BYTES = 155648;

__device__ __forceinline__ int crow(int reg, int h) { return (reg & 3) + 8 * (reg >> 2) + 4 * h; }
__device__ __forceinline__ float wave_sum(float v) {
#pragma unroll
    for (int o = 1; o < 64; o <<= 1) v += __shfl_xor(v, o);
    return v;
}
__device__ __forceinline__ float bf2f(bf16_t v) { return __uint_as_float((unsigned)v << 16); }
__device__ __forceinline__ bf16_t f2bf(float v) { return (bf16_t)(pk2(v, 0.f) & 0xffffu); }

typedef __attribute__((address_space(1))) unsigned gu32;
#define XB_TMO      128
#define XB_XCNT(j)  (256  + 64 * (j))
#define XB_XSUB(j)  (1280 + 64 * (j))
#define XB_XGEN(j)  (2304 + 64 * (j))
#define XB_TOP      3328
#define XB_TOPGEN   3392
#define XCD_BAR_WORDS 3456
#define XB_SPIN_CAP (1u << 18)

__device__ __forceinline__ unsigned xb_ld(unsigned* p)              { return __hip_atomic_load(p, __ATOMIC_RELAXED, __HIP_MEMORY_SCOPE_AGENT); }
__device__ __forceinline__ unsigned xb_add(unsigned* p, unsigned v) { return __hip_atomic_fetch_add(p, v, __ATOMIC_RELAXED, __HIP_MEMORY_SCOPE_AGENT); }
__device__ __forceinline__ unsigned xb_xcc_id() { return (unsigned)__builtin_amdgcn_s_getreg((3 << 11) | 20) & 0xFu; }
#define XB_SPIN(cond, bar) do { unsigned _sp = 0; while (cond) { \
    if ((++_sp & 255u) == 0u) { if (xb_ld(&(bar)[XB_TMO])) break; if (_sp > XB_SPIN_CAP) { atomicAdd(&(bar)[XB_TMO], 1u); break; } } } } while (0)

struct XcdBarrier {
    unsigned* bar; unsigned x;
    volatile LAS unsigned* st;
};

__device__ __forceinline__ XcdBarrier xcd_barrier_post(unsigned* bar, volatile LAS unsigned* st) {
    XcdBarrier b; b.bar = bar; b.x = xb_xcc_id(); b.st = st;
    if (threadIdx.x == 0) (void)xb_add(&bar[XB_XCNT(b.x)], 1u);
    return b;
}
__device__ __forceinline__ void xcd_barrier_complete(unsigned* bar, unsigned x, unsigned& nloc, unsigned& nx) {
    const unsigned G = gridDim.x * gridDim.y * gridDim.z;
    unsigned sum, cnt, mine, sp = 0u;
    for (;;) {
        sum = 0u; cnt = 0u; mine = 0u;
#pragma unroll
        for (unsigned j = 0; j < 16; ++j) { const unsigned c = xb_ld(&bar[XB_XCNT(j)]); sum += c; cnt += (c > 0u) ? 1u : 0u; mine = (j == x) ? c : mine; }
        if (sum == G) break;
        __builtin_amdgcn_s_sleep(1);
        if ((++sp & 255u) == 0u) { if (xb_ld(&bar[XB_TMO])) break; if (sp > XB_SPIN_CAP) { atomicAdd(&bar[XB_TMO], 1u); break; } }
    }
    nloc = mine > 0u ? mine : 1u; nx = cnt > 0u ? cnt : 1u;
}

__device__ __forceinline__ void xcd_barrier(const XcdBarrier& b) {
    asm volatile("s_waitcnt vmcnt(0)" ::: "memory");
    __syncthreads();
    if (threadIdx.x == 0) {
        unsigned* bar = b.bar;
        __builtin_amdgcn_s_waitcnt(0);
        unsigned nloc = b.st[0], nx = b.st[1];
        if (nloc == 0u) { xcd_barrier_complete(bar, b.x, nloc, nx); b.st[0] = nloc; b.st[1] = nx; }
        const unsigned old = xb_add(&bar[XB_XSUB(b.x)], 1u);
        const unsigned gen = old / nloc;
        if (old + 1u == (gen + 1u) * nloc) {
            __builtin_amdgcn_fence(__ATOMIC_RELEASE, "agent");
            asm volatile("s_waitcnt vmcnt(0)" ::: "memory");
            const unsigned og = xb_add(&bar[XB_TOP], 1u);
            const unsigned tg = og / nx;
            if (og + 1u == (tg + 1u) * nx) xb_add(&bar[XB_TOPGEN], 1u);
            else XB_SPIN(xb_ld(&bar[XB_TOPGEN]) == tg, bar);
            __builtin_amdgcn_fence(__ATOMIC_ACQUIRE, "agent");
            xb_add(&bar[XB_XGEN(b.x)], 1u);
            asm volatile("s_waitcnt vmcnt(0)" ::: "memory");
        } else {
            XB_SPIN(xb_ld(&bar[XB_XGEN(b.x)]) == gen, bar);
            __builtin_amdgcn_fence(__ATOMIC_ACQUIRE, "agent");
            asm volatile("s_waitcnt vmcnt(0)" ::: "memory");
        }
    }
    __syncthreads();
}

#ifdef NT_P0
#define P0LD(p) __builtin_nontemporal_load(p)
#else
#define P0LD(p) (*(p))
#endif
__device__ __forceinline__ void tr_item(const float* W, const float* gain, int K, int N, bf16_t* WT, LAS float* scr, int item, int lane) {
    const int nblk = N / 32, kb = item / nblk, nb = item % nblk, k0 = 64 * kb, n0 = 32 * nb;
    float wv[32];
#pragma unroll
    for (int i = 0; i < 32; ++i) wv[i] = P0LD(&W[(size_t)(k0 + 2 * i + (lane >> 5)) * N + n0 + (lane & 31)]);
    if (gain) {
#pragma unroll
        for (int i = 0; i < 32; ++i) wv[i] *= gain[k0 + 2 * i + (lane >> 5)]; }
#pragma unroll
    for (int i = 0; i < 32; ++i) scr[(2 * i + (lane >> 5)) * 33 + (lane & 31)] = wv[i];
    LDS_WAIT(); asm volatile("" ::: "memory");
    const int c = lane & 7;
#pragma unroll
    for (int jj = 0; jj < 4; ++jj) { const int n = (lane >> 3) + 8 * jj; const LAS float* s = scr + (8 * c) * 33 + n;
        u32x4 o; o.x = pk2(s[0 * 33], s[1 * 33]); o.y = pk2(s[2 * 33], s[3 * 33]); o.z = pk2(s[4 * 33], s[5 * 33]); o.w = pk2(s[6 * 33], s[7 * 33]);
#ifdef NT2
        __builtin_nontemporal_store(o, (u32x4*)(WT + (size_t)(n0 + n) * K + k0 + 8 * c)); }
#else
        *(u32x4*)(WT + (size_t)(n0 + n) * K + k0 + 8 * c) = o; }
#endif
    LDS_WAIT(); asm volatile("" ::: "memory");
}

struct Args { const float* in[13]; float* out; unsigned char* ws; };

#define OPAQUE_IDS() int tid_ = threadIdx.x, bx_ = blockIdx.x; asm volatile("" : "+v"(tid_), "+s"(bx_)); const int tid = tid_, lane = tid & 63, wave = __builtin_amdgcn_readfirstlane(tid >> 6); \
    const int G = gridDim.x, vcu = (G % 8 == 0) ? (bx_ % 8) * (G / 8) + bx_ / 8 : bx_; (void)tid; (void)lane; (void)wave; (void)vcu
__device__ __forceinline__ void p0_prologue(const Args& a, LAS unsigned char* lds) {
    OPAQUE_IDS();
    unsigned char* ws = a.ws;
    LAS float* scr = (LAS float*)(lds + wave * 16384);
    const int gw = vcu * 8 + wave, NGW = G * 8;
    constexpr int I_QKV = 16 * 96, I_O = 16 * 32, I_IN = 16 * 128, I_OUT = 32 * 32, I_1 = 16 * 128, I_2 = 64 * 32;
    constexpr int NITEMS = 2 * I_QKV + 2 * I_O + 2 * I_IN + 2 * I_OUT + 4 * I_1 + 4 * I_2;
    for (int it = gw; it < NITEMS; it += NGW) {
        int r = it; const float* W; const float* gain = nullptr; int K, N; bf16_t* WT;
        if (r < 2 * I_QKV) { const int j = r / I_QKV; r -= j * I_QKV; W = a.in[3] + (size_t)j * D * 3 * D; gain = a.in[1] + (size_t)(2 * j) * D; K = D; N = 3 * D; WT = (bf16_t*)(ws + WS_WQKV) + (size_t)j * 3 * D * D; }
        else if ((r -= 2 * I_QKV) < 2 * I_O) { const int j = r / I_O; r -= j * I_O; W = a.in[4] + (size_t)j * D * D; K = D; N = D; WT = (bf16_t*)(ws + WS_WO) + (size_t)j * D * D; }
        else if ((r -= 2 * I_O) < 2 * I_IN) { const int j = r / I_IN; r -= j * I_IN; W = a.in[5] + (size_t)j * D * 2 * SF; gain = a.in[1] + (size_t)(2 * j + 1) * D; K = D; N = 2 * SF; WT = (bf16_t*)(ws + WS_WIN) + (size_t)j * 2 * SF * D; }
        else if ((r -= 2 * I_IN) < 2 * I_OUT) { const int j = r / I_OUT; r -= j * I_OUT; W = a.in[9] + (size_t)j * SF * D; K = SF; N = D; WT = (bf16_t*)(ws + WS_WOUT) + (size_t)j * D * SF; }
        else if ((r -= 2 * I_OUT) < 4 * I_1) { const int j = r / I_1; r -= j * I_1; W = a.in[10] + (size_t)j * D * FF; gain = a.in[2] + (size_t)j * D; K = D; N = FF; WT = (bf16_t*)(ws + WS_W1) + (size_t)j * FF * D; }
        else { r -= 4 * I_1; const int j = r / I_2; r -= j * I_2; W = a.in[11] + (size_t)j * FF * D; K = FF; N = D; WT = (bf16_t*)(ws + WS_W2) + (size_t)j * D * FF; }
        tr_item(W, gain, K, N, WT, scr, r, lane);
    }
    const float* x = a.in[0]; bf16_t* XB = (bf16_t*)(ws + WS_XB); bf16_t* XL = (bf16_t*)(ws + WS_XL); float* stat = (float*)(ws + WS_STAT);
    for (int m0 = gw; m0 < M; m0 += 4 * NGW) {
        f32x4 v[4][4];
#pragma unroll
        for (int q = 0; q < 4; ++q) { const int m = m0 + q * NGW; const f32x4* xr = (const f32x4*)(x + (size_t)(m < M ? m : m0) * D) + lane;
#pragma unroll
            for (int jj = 0; jj < 4; ++jj) v[q][jj] = P0LD(&xr[64 * jj]); }
#pragma unroll
        for (int q = 0; q < 4; ++q) { const int m = m0 + q * NGW; if (m >= M) break; float s = 0.f;
#pragma unroll
            for (int jj = 0; jj < 4; ++jj) s += (v[q][jj].x * v[q][jj].x + v[q][jj].y * v[q][jj].y) + (v[q][jj].z * v[q][jj].z + v[q][jj].w * v[q][jj].w);
            s = wave_sum(s); if (lane < 16) stat[(size_t)m * 16 + lane] = (lane == 0) ? s : 0.f;
            u32x2* o8 = (u32x2*)(XB + (size_t)m * D) + lane; u32x2* l8 = (u32x2*)(XL + (size_t)m * D) + lane;
#pragma unroll
            for (int jj = 0; jj < 4; ++jj) { u32x2 w, l; w.x = pk2(v[q][jj].x, v[q][jj].y); w.y = pk2(v[q][jj].z, v[q][jj].w);
                l.x = pk2(v[q][jj].x - __uint_as_float(w.x << 16), v[q][jj].y - __uint_as_float(w.x & 0xffff0000u));
                l.y = pk2(v[q][jj].z - __uint_as_float(w.y << 16), v[q][jj].w - __uint_as_float(w.y & 0xffff0000u));
#ifdef NT2
                __builtin_nontemporal_store(w, &o8[64 * jj]); __builtin_nontemporal_store(l, &l8[64 * jj]);
#else
                o8[64 * jj] = w; if (RES_LO) l8[64 * jj] = l;
#endif
            } }
    }
}

__device__ __forceinline__ void attn_phase(const bf16_t* __restrict__ Q, const bf16_t* __restrict__ Kb, const bf16_t* __restrict__ VT, bf16_t* __restrict__ O) {
    OPAQUE_IDS();
    const int r = lane & 31, h = lane >> 5;
    for (int u = vcu; u < BATCH * NH * (SEQ / 256); u += G) {
        const int qb = u & 7, bh = u >> 3, hh = bh & 15, b = bh >> 4;
        const int t0 = qb * 256 + wave * 32;
        const size_t rowb = (size_t)b * SEQ;
        const size_t tile0 = (size_t)((b * NH + hh) * (SEQ / 32)) << 11;
        bf16x8 qf[4];
        { const bf16_t* qp = Q + tile0 + ((size_t)(t0 >> 5) << 11) + lane * 8;
#pragma unroll
          for (int d0 = 0; d0 < 4; ++d0) qf[d0] = *(const bf16x8*)(qp + d0 * 512); }
        f32x16 o0, o1;
#pragma unroll
        for (int i = 0; i < 16; ++i) { o0[i] = 0.f; o1[i] = 0.f; }
        float carry = 1.f;
        const bf16_t* kbase = Kb + tile0 + lane * 8;
        const bf16_t* vbase = VT + tile0 + lane * 4;
        bf16x8 kf[4]; s16x4 va[2][2][2];
#define ATT_LOAD(KF, VA, s0_) do { const bf16_t* kp_ = kbase + ((size_t)((s0_) >> 5) << 11); const bf16_t* vp_ = vbase + ((size_t)((s0_) >> 5) << 11); \
        _Pragma("unroll") for (int d0 = 0; d0 < 4; ++d0) KF[d0] = *(const bf16x8*)(kp_ + d0 * 512); \
        _Pragma("unroll") for (int db = 0; db < 2; ++db) _Pragma("unroll") for (int s = 0; s < 2; ++s) { VA[db][s][0] = *(const s16x4*)(vp_ + ((db * 2 + s) * 2 + 0) * 256); VA[db][s][1] = *(const s16x4*)(vp_ + ((db * 2 + s) * 2 + 1) * 256); } } while (0)
        ATT_LOAD(kf, va, t0);
        bf16x8 kn[4]; s16x4 vn[2][2][2];
        { const int sn = t0 >= 32 ? t0 - 32 : 0; ATT_LOAD(kn, vn, sn); }
        for (int kt = t0 >> 5; kt >= 0; --kt) {
            const int s0 = kt * 32;
            bf16x8 k2[4]; s16x4 v2[2][2][2];
            { const int sn = kt > 1 ? s0 - 64 : 0; ATT_LOAD(k2, v2, sn); }
            f32x16 X;
#pragma unroll
            for (int i = 0; i < 16; ++i) X[i] = 0.f;
#pragma unroll
            for (int d0 = 0; d0 < 4; ++d0) X = MFMA32(kf[d0], qf[d0], X);
            const bool diag = (s0 == t0);
            float Ev[16], Dv[16], A[16];
#pragma unroll
            for (int i = 0; i < 16; ++i) { const float z = fminf(X[i], 31.f); float E = __builtin_amdgcn_exp2f(z);
                if (diag) E = (crow(i, h) < r) ? E : 0.f;
                Ev[i] = E; Dv[i] = 1.f + E; }
            float gp[4], og[4];
#pragma unroll
            for (int g = 0; g < 4; ++g) { gp[g] = __builtin_amdgcn_rcpf((Dv[4 * g] * Dv[4 * g + 1]) * (Dv[4 * g + 2] * Dv[4 * g + 3])); og[g] = __shfl_xor(gp[g], 32); }
            float sp = carry;
#pragma unroll
            for (int g = 3; g >= 0; --g) { const float gs = (h == 0) ? sp * og[g] : sp;
                const float gi = gs * gp[g], t1 = gi * Dv[4 * g], t2 = t1 * Dv[4 * g + 1], t3 = t2 * Dv[4 * g + 2];
                A[4 * g] = Ev[4 * g] * gi; A[4 * g + 1] = Ev[4 * g + 1] * t1; A[4 * g + 2] = Ev[4 * g + 2] * t2; A[4 * g + 3] = Ev[4 * g + 3] * t3;
                sp *= gp[g] * og[g]; }
            carry = sp;
            bf16x8 pf[2];
#pragma unroll
            for (int s = 0; s < 2; ++s) { u32x4 p; p.x = pk2(A[8 * s], A[8 * s + 1]); p.y = pk2(A[8 * s + 2], A[8 * s + 3]); p.z = pk2(A[8 * s + 4], A[8 * s + 5]); p.w = pk2(A[8 * s + 6], A[8 * s + 7]); pf[s] = __builtin_bit_cast(bf16x8, p); }
#pragma unroll
            for (int s = 0; s < 2; ++s) {
                const bf16x8 v0 = __builtin_shufflevector(va[0][s][0], va[0][s][1], 0, 1, 2, 3, 4, 5, 6, 7);
                const bf16x8 v1 = __builtin_shufflevector(va[1][s][0], va[1][s][1], 0, 1, 2, 3, 4, 5, 6, 7);
                o0 = MFMA32(pf[s], v0, o0); o1 = MFMA32(pf[s], v1, o1); }
            if (__builtin_amdgcn_ballot_w64(carry >= 1.17549435e-38f) == 0ull) break;
#pragma unroll
            for (int d0 = 0; d0 < 4; ++d0) { kf[d0] = kn[d0]; kn[d0] = k2[d0]; }
#pragma unroll
            for (int db = 0; db < 2; ++db)
#pragma unroll
                for (int s = 0; s < 2; ++s) { va[db][s][0] = vn[db][s][0]; va[db][s][1] = vn[db][s][1]; vn[db][s][0] = v2[db][s][0]; vn[db][s][1] = v2[db][s][1]; }
        }
#undef ATT_LOAD
        bf16_t* op = O + (rowb + t0) * D + hh * HD + r;
#pragma unroll
        for (int i = 0; i < 16; ++i) { const size_t ro = (size_t)crow(i, h) * D;
#ifdef NT2
            __builtin_nontemporal_store(f2bf(o0[i]), op + ro); __builtin_nontemporal_store(f2bf(o1[i]), op + ro + 32);
#else
            op[ro] = f2bf(o0[i]); op[ro + 32] = f2bf(o1[i]);
#endif
        }
    }
}

#define MFMA16(a, b, c) __builtin_amdgcn_mfma_f32_16x16x32_bf16((a), (b), (c), 0, 0, 0)
template <bool REAL> __device__ __forceinline__ void sgu_mix_phase(LAS unsigned char* lds, const float* wsj, const float* bsj, const float* gainj, const float* vstat, const bf16_t* VT2, bf16_t* UY) {
    OPAQUE_IDS();
    const int q = lane >> 4, tl = lane & 15;
    constexpr int ROWB = 272, NU = BATCH * (SEQ / SC) * SG;
    LAS float* rsT = (LAS float*)(lds + 128 * ROWB);
    const int g = vcu & 7;
    const int c0 = g * SGW + wave * 32;
    const int c4 = (tid & 31) * 4;
    f32x4 wsr[8];
    { const float* wsg = wsj + (size_t)g * SC * SC;
#pragma unroll
      for (int it = 0; it < 8; ++it) wsr[it] = *(const f32x4*)(wsg + ((tid >> 5) + 16 * it) * SC + c4); }
    const f32x4 g0 = *(const f32x4*)(gainj + c0 + 8 * q), g1 = *(const f32x4*)(gainj + c0 + 8 * q + 4);
    bf16x8 va[4][2]; u32x4 uu[8]; f32x4 vs4;
#ifdef NT2
#define MIXLD(T, p) __builtin_nontemporal_load((const T*)(p))
#else
#define MIXLD(T, p) (*(const T*)(p))
#endif
#define MIX_LOAD(VA, UU, VS, u_) do { const size_t tok0_ = (size_t)((u_) >> 3) * SC; \
        const bf16_t* vp_ = VT2 + (size_t)(c0 + 8 * (tl >> 2) + (tl & 3)) * PV + tok0_ + q * 8; \
        _Pragma("unroll") for (int ks = 0; ks < 4; ++ks) { VA[ks][0] = MIXLD(bf16x8, vp_ + ks * 32); VA[ks][1] = MIXLD(bf16x8, vp_ + 4 * PV + ks * 32); } \
        const bf16_t* up_ = UY + (tok0_ + tl) * SF + c0 + 8 * q; \
        _Pragma("unroll") for (int tb = 0; tb < 8; ++tb) UU[tb] = MIXLD(u32x4, up_ + (size_t)tb * 16 * SF); \
        VS = *(const f32x4*)(vstat + (tok0_ + (tid >> 2)) * 16 + (tid & 3) * 4); } while (0)
    if ((G & 7) != 0) return;
    if (vcu < NU) MIX_LOAD(va, uu, vs4, vcu);
    for (int u = vcu; u < NU; u += G) {
        const size_t tok0 = (size_t)(u >> 3) * SC;
        { float sq = (vs4[0] + vs4[1]) + (vs4[2] + vs4[3]); sq += __shfl_xor(sq, 1); sq += __shfl_xor(sq, 2);
          if ((tid & 3) == 0) rsT[tid >> 2] = __builtin_amdgcn_rsqf(sq * (1.f / SF) + EPS); }
        bf16x8 vn[4][2]; u32x4 un[8]; f32x4 vsn;
        { const int un_ = (u + G < NU) ? u + G : u; MIX_LOAD(vn, un, vsn, un_); }
        __syncthreads();
        { const f32x4 rs = *(const LAS f32x4*)(rsT + c4);
#pragma unroll
          for (int it = 0; it < 8; ++it) { const int t = (tid >> 5) + 16 * it; const f32x4 w = wsr[it];
              const float a0 = (c4 + 0 <= t) ? w[0] * rs[0] : 0.f, a1 = (c4 + 1 <= t) ? w[1] * rs[1] : 0.f, a2 = (c4 + 2 <= t) ? w[2] * rs[2] : 0.f, a3 = (c4 + 3 <= t) ? w[3] * rs[3] : 0.f;
              u32x2 p; p.x = pk2(a0, a1); p.y = pk2(a2, a3); *(LAS u32x2*)(lds + t * ROWB + c4 * 2) = p; } }
        __syncthreads();
        bf16_t* up = UY + (tok0 + tl) * SF + c0 + 8 * q;
#pragma unroll
        for (int tb = 0; tb < 8; ++tb) {
            f32x4 a0 = {0.f, 0.f, 0.f, 0.f}, a1 = {0.f, 0.f, 0.f, 0.f};
#pragma unroll
            for (int ks = 0; ks <= (tb >> 1); ++ks) { const bf16x8 bfr = *(const LAS bf16x8*)(lds + (tb * 16 + tl) * ROWB + (ks * 32 + q * 8) * 2);
                a0 = MFMA16(va[ks][0], bfr, a0); a1 = MFMA16(va[ks][1], bfr, a1); }
            const float bsv = bsj[g * SC + tb * 16 + tl];
            const u32x4 w = uu[tb]; u32x4 o;
            o.x = pk2(__uint_as_float(w.x << 16) * (g0[0] * a0[0] + bsv), __uint_as_float(w.x & 0xffff0000u) * (g0[1] * a0[1] + bsv));
            o.y = pk2(__uint_as_float(w.y << 16) * (g0[2] * a0[2] + bsv), __uint_as_float(w.y & 0xffff0000u) * (g0[3] * a0[3] + bsv));
            o.z = pk2(__uint_as_float(w.z << 16) * (g1[0] * a1[0] + bsv), __uint_as_float(w.z & 0xffff0000u) * (g1[1] * a1[1] + bsv));
            o.w = pk2(__uint_as_float(w.w << 16) * (g1[2] * a1[2] + bsv), __uint_as_float(w.w & 0xffff0000u) * (g1[3] * a1[3] + bsv));
            if (REAL || o.x == 0x12345678u) {
#if 1
                __builtin_nontemporal_store(o, (u32x4*)(up + (size_t)tb * 16 * SF));
#else
                *(u32x4*)(up + (size_t)tb * 16 * SF) = o;
#endif
            }
        }
#pragma unroll
        for (int ks = 0; ks < 4; ++ks) { va[ks][0] = vn[ks][0]; va[ks][1] = vn[ks][1]; }
#pragma unroll
        for (int tb = 0; tb < 8; ++tb) uu[tb] = un[tb];
        vs4 = vsn;
    }
#undef MIX_LOAD
}

#ifdef TSEL
#define STAMP(id) do { const unsigned long long tn_ = __builtin_amdgcn_s_memrealtime(); if ((((unsigned)TSEL) >> (id)) & 1u) tsum += tn_ - tprev; tprev = tn_; } while (0)
#else
#define STAMP(id) do { } while (0)
#endif
struct FastSync { XcdBarrier b; __device__ __forceinline__ void sync() const { xcd_barrier(b); } };
template <int PAR> __device__ __forceinline__ void layer_fwd(const Args& a, const FastSync& grid, LAS unsigned char* lds, const int i, unsigned long long& tprev, unsigned long long& tsum) {
    const int G = gridDim.x, bx = blockIdx.x;
    unsigned char* ws = a.ws;
    float* stat = (float*)(ws + WS_STAT);
    bf16_t* XB = (bf16_t*)(ws + WS_XB); bf16_t* XL = (bf16_t*)(ws + WS_XL); (void)XL;
    bf16_t* BIG = (bf16_t*)(ws + WS_BIG);
    bf16_t* Qb = BIG; bf16_t* Kb = BIG + (size_t)M * D; bf16_t* Ob = BIG + 2 * (size_t)M * D; bf16_t* VT = BIG + 3 * (size_t)M * D;
    bf16_t* UY = BIG; bf16_t* VT2 = BIG + (size_t)M * SF; bf16_t* Hb = BIG;
    (void)Qb; (void)Kb; (void)VT; (void)Ob; (void)UY; (void)VT2; (void)Hb;
        const int j = i >> 1;
        const float* stat_in = stat + (size_t)(2 * i) * STAT_ELEMS; float* stat_mid = stat + (size_t)(2 * i + 1) * STAT_ELEMS; float* stat_out = stat + (size_t)(2 * i + 2) * STAT_ELEMS;
        if constexpr (PAR == 0) {
            const bf16_t* Wqkv = (const bf16_t*)(ws + WS_WQKV) + (size_t)j * 3 * D * D;
            { pg8::Gemm g{XB, Wqkv, M, 2 * D, D}; pg8::StaticOrder S; S.init(M, 2 * D, G, bx);
              pg8::EpiRow<0, true> E{Qb, D, stat_in, 1.f / D, D, (size_t)M * D, QSCALE};
              pg8::gemm_phase<pg8::EpiRow<0, true>, pg8::StaticOrder, PG_ALIGN, PG_SP2>(lds, g, S, E);

            }
            { pg8::Gemm g{Wqkv + (size_t)2 * D * D, XB, D, M, D}; pg8::StaticOrder S; S.init(D, M, G, bx);
              pg8::EpiCol<0, false, true> E{VT, PV, stat_in, 1.f / D, nullptr};
              pg8::gemm_phase<pg8::EpiCol<0, false, true>, pg8::StaticOrder, PG_ALIGN, PG_SP2>(lds, g, S, E);

            }
            grid.sync(); STAMP(1 + 5 * i + 0);
#ifndef NO_ATT
            attn_phase(Qb, Kb, VT, Ob);
#ifdef PROBE_ATT2
            attn_phase(Qb, Kb, VT, Ob);
#endif
#endif
            grid.sync(); STAMP(1 + 5 * i + 1);
            { pg8::Gemm g{Ob, (const bf16_t*)(ws + WS_WO) + (size_t)j * D * D, M, D, D}; pg8::StaticOrder S; S.init(M, D, G, bx);
              pg8::EpiRes E{XB, XL, stat_mid, D};
              pg8::gemm_phase<pg8::EpiRes, pg8::StaticOrder, PG_ALIGN, PG_SP2>(lds, g, S, E);
#ifdef PROBE_WO
              if (i == 0) pg8::gemm_phase<pg8::EpiRes, pg8::StaticOrder, PG_ALIGN, PG_SP2>(lds, g, S, E);
#endif
            }
            grid.sync(); STAMP(1 + 5 * i + 2);
        } else {
            const bf16_t* Win = (const bf16_t*)(ws + WS_WIN) + (size_t)j * 2 * SF * D;
            float* vstat = stat + (size_t)(9 + j) * STAT_ELEMS;
            { pg8::Gemm g{XB, Win, M, SF, D}; pg8::StaticOrder S; S.init(M, SF, G, bx);
              pg8::EpiRow<2> E{UY, SF, stat_in, 1.f / D, 0, 0, 1.f};
              pg8::gemm_phase<pg8::EpiRow<2>, pg8::StaticOrder, PG_ALIGN, PG_SP2>(lds, g, S, E);
#ifdef PROBE_GC
              pg8::gemm_phase<pg8::EpiRow<2>, pg8::StaticOrder, PG_ALIGN, PG_SP2>(lds, g, S, E);
#endif
            }
            { pg8::Gemm g{Win + (size_t)SF * D, XB, SF, M, D}; pg8::StaticOrder S; S.init(SF, M, G, bx);
              pg8::EpiCol<2, true> E{VT2, PV, stat_in, 1.f / D, vstat};
              pg8::gemm_phase<pg8::EpiCol<2, true>, pg8::StaticOrder, PG_ALIGN, PG_SP2>(lds, g, S, E);
#ifdef PROBE_GD
              pg8::gemm_phase<pg8::EpiCol<2, true>, pg8::StaticOrder, PG_ALIGN, PG_SP2>(lds, g, S, E);
#endif
            }
            grid.sync(); STAMP(1 + 5 * i + 0);
#ifndef NO_MIX
#ifdef PROBE_MIX2
            sgu_mix_phase<false>(lds, a.in[7] + (size_t)j * SG * SC * SC, a.in[8] + (size_t)j * SG * SC, a.in[6] + (size_t)j * SF, vstat, VT2, UY);
#endif
            sgu_mix_phase<true>(lds, a.in[7] + (size_t)j * SG * SC * SC, a.in[8] + (size_t)j * SG * SC, a.in[6] + (size_t)j * SF, vstat, VT2, UY);
#endif
            grid.sync(); STAMP(1 + 5 * i + 1);
            { pg8::Gemm g{UY, (const bf16_t*)(ws + WS_WOUT) + (size_t)j * D * SF, M, D, SF}; pg8::StaticOrder S; S.init(M, D, G, bx);
              pg8::EpiRes E{XB, XL, stat_mid, D};
              pg8::gemm_phase<pg8::EpiRes, pg8::StaticOrder, PG_ALIGN, PG_SP2>(lds, g, S, E); }
            grid.sync(); STAMP(1 + 5 * i + 2);
        }
#ifdef VAR_W1
        if (i == 0) { grid.sync(); tprev = __builtin_amdgcn_s_memrealtime();
#ifdef VAR_STAG
          if ((bx >> 3) & 3) { const unsigned long long t0_ = __builtin_amdgcn_s_memrealtime(); while (__builtin_amdgcn_s_memrealtime() - t0_ < (unsigned long long)(VAR_STAG * ((bx >> 3) & 3))) __builtin_amdgcn_s_sleep(8); }
#endif
          { pg8::Gemm g{XB, (const bf16_t*)(ws + WS_W1) + (size_t)i * FF * D, M, FF, D}; pg8::StaticOrder S; S.init(M, FF, G, bx);
            pg8::EpiVar<VAR_W1> E{Hb, FF, stat_mid, 1.f / D};
            pg8::gemm_phase<pg8::EpiVar<VAR_W1>, pg8::StaticOrder, PG_ALIGN, PG_SP2>(lds, g, S, E); }
          grid.sync(); STAMP(30); }
#endif
#ifdef STAGGER_W1
        if (bx & 8) { const unsigned long long t0_ = __builtin_amdgcn_s_memrealtime(); while (__builtin_amdgcn_s_memrealtime() - t0_ < (unsigned long long)STAGGER_W1) __builtin_amdgcn_s_sleep(8); }
#endif
        { pg8::Gemm g{XB, (const bf16_t*)(ws + WS_W1) + (size_t)i * FF * D, M, FF, D}; pg8::StaticOrder S; S.init(M, FF, G, bx);
          pg8::EpiRow<1> E{Hb, FF, stat_mid, 1.f / D, 0, 0, 1.f};
          pg8::gemm_phase<pg8::EpiRow<1>, pg8::StaticOrder, PG_ALIGN, PG_SP2>(lds, g, S, E);
#ifdef PROBE_W12
          pg8::gemm_phase<pg8::EpiRow<1>, pg8::StaticOrder, PG_ALIGN, PG_SP2>(lds, g, S, E);
#endif
        }
        grid.sync(); STAMP(1 + 5 * i + 3);
#ifdef PROBE_W2
        { pg8::Gemm g{Hb, (const bf16_t*)(ws + WS_W2) + (size_t)i * D * FF, M, D, FF}; pg8::StaticOrder S; S.init(M, D, G, bx);
          pg8::EpiRow<0> E{XB, D, stat_mid, 1.f / D, 0, 0, 1.f};
          pg8::gemm_phase<pg8::EpiRow<0>, pg8::StaticOrder, PG_ALIGN, PG_SP2>(lds, g, S, E); }
#endif
        { pg8::Gemm g{Hb, (const bf16_t*)(ws + WS_W2) + (size_t)i * D * FF, M, D, FF}; pg8::StaticOrder S; S.init(M, D, G, bx);
          pg8::EpiRes E{XB, XL, stat_out, D};
          pg8::gemm_phase<pg8::EpiRes, pg8::StaticOrder, PG_ALIGN, PG_SP2>(lds, g, S, E); }
        grid.sync(); STAMP(1 + 5 * i + 4);

}

__global__ void __launch_bounds__(512, 2) fwd_megakernel(Args a) {
    extern __shared__ __attribute__((aligned(16))) unsigned char lds_raw[];
    cg::grid_group grid = cg::this_grid();
    LAS unsigned char* lds = (LAS unsigned char*)lds_raw;
    unsigned* barw = (unsigned*)(a.ws + WS_END + 4096);
    if (blockIdx.x == 0) for (int w = threadIdx.x; w < XCD_BAR_WORDS; w += 512) barw[w] = 0u;
    volatile LAS unsigned* bst = (volatile LAS unsigned*)(lds + 131072 + 64);
    if (threadIdx.x == 0) { bst[0] = 0u; bst[1] = 0u; }
    __threadfence(); __syncthreads();
    const int G = gridDim.x, bx = blockIdx.x;
    unsigned char* ws = a.ws;
    float* stat = (float*)(ws + WS_STAT);
    bf16_t* XB = (bf16_t*)(ws + WS_XB); bf16_t* XL = (bf16_t*)(ws + WS_XL); (void)XL;
    bf16_t* BIG = (bf16_t*)(ws + WS_BIG);
    bf16_t* Qb = BIG; bf16_t* Kb = BIG + (size_t)M * D; bf16_t* Ob = BIG + 2 * (size_t)M * D; bf16_t* VT = BIG + 3 * (size_t)M * D;
    bf16_t* UY = BIG; bf16_t* VT2 = BIG + (size_t)M * SF; bf16_t* Hb = BIG;

#ifdef TSEL
    const unsigned long long t_begin = __builtin_amdgcn_s_memrealtime();
#endif
#ifndef NO_P0
    p0_prologue(a, lds);
#ifdef PROBE_P02
    __syncthreads(); p0_prologue(a, lds);
#endif
#endif
    grid.sync();
    FastSync fsync; fsync.b = xcd_barrier_post(barw, bst);
    unsigned long long tprev = 0ull, tsum = 0ull;
#ifdef TSEL
    tprev = t_begin; STAMP(0);
#endif

#ifdef LAYER_LOOP
#pragma unroll 1
    for (int jj = 0; jj < DEPTH; jj += 2) { layer_fwd<0>(a, fsync, lds, jj, tprev, tsum); layer_fwd<1>(a, fsync, lds, jj + 1, tprev, tsum); }
#else
    layer_fwd<0>(a, fsync, lds, 0, tprev, tsum); layer_fwd<1>(a, fsync, lds, 1, tprev, tsum); layer_fwd<0>(a, fsync, lds, 2, tprev, tsum); layer_fwd<1>(a, fsync, lds, 3, tprev, tsum);
#endif
#ifdef TSEL
    float tdelta = 0.f;
    { unsigned long long* tw = (unsigned long long*)(ws + WS_END);
      if (blockIdx.x == 0 && threadIdx.x == 0) { *tw = tsum; __threadfence(); }
      grid.sync();
      tdelta = (float)(*(volatile unsigned long long*)tw) * 1e-7f; tprev = __builtin_amdgcn_s_memrealtime(); }
#ifdef TCAL
    tdelta = TCAL;
#endif
#endif
#ifdef NT2
#define FINLD(p) __builtin_nontemporal_load(p)
#else
#define FINLD(p) (*(p))
#endif
    { OPAQUE_IDS(); const float* st = stat + (size_t)8 * STAT_ELEMS; const f32x4* gn = (const f32x4*)a.in[12] + lane; const int gw = vcu * 8 + wave, NGW = G * 8;
      const bf16_t* XBf = (const bf16_t*)(ws + WS_XB); const bf16_t* XLf = (const bf16_t*)(ws + WS_XL);
      f32x4 gv[4];
#pragma unroll
      for (int jj = 0; jj < 4; ++jj) gv[jj] = gn[64 * jj];
      for (int m0 = gw; m0 < M; m0 += 4 * NGW) {
          u32x2 hw[4][4], lw[4][4]; float sp[4];
#pragma unroll
          for (int q = 0; q < 4; ++q) { const int m = (m0 + q * NGW < M) ? m0 + q * NGW : m0; const u32x2* h8 = (const u32x2*)(XBf + (size_t)m * D) + lane; const u32x2* l8 = (const u32x2*)(XLf + (size_t)m * D) + lane;
              sp[q] = lane < 16 ? st[(size_t)m * 16 + lane] : 0.f;
#pragma unroll
              for (int jj = 0; jj < 4; ++jj) { hw[q][jj] = FINLD(&h8[64 * jj]); lw[q][jj] = RES_LO ? FINLD(&l8[64 * jj]) : (u32x2){0u, 0u}; } }
#pragma unroll
          for (int q = 0; q < 4; ++q) { const int m = m0 + q * NGW; if (m >= M) break; f32x4* xr = (f32x4*)(a.out + (size_t)m * D) + lane;
              const float rs = __builtin_amdgcn_rsqf(wave_sum(sp[q]) * (1.f / D) + EPS);
#pragma unroll
              for (int jj = 0; jj < 4; ++jj) { const u32x2 h2 = hw[q][jj], l2 = lw[q][jj]; f32x4 v;
                  v.x = __uint_as_float(h2.x << 16) + __uint_as_float(l2.x << 16); v.y = __uint_as_float(h2.x & 0xffff0000u) + __uint_as_float(l2.x & 0xffff0000u);
                  v.z = __uint_as_float(h2.y << 16) + __uint_as_float(l2.y << 16); v.w = __uint_as_float(h2.y & 0xffff0000u) + __uint_as_float(l2.y & 0xffff0000u);
                  v = v * rs * gv[jj];
#if defined(TSEL) && !defined(TFINAL)
                  if (jj == 0 && lane < 4) v = v + tdelta;
#endif
                  __builtin_nontemporal_store(v, &xr[64 * jj]); } } }
      }
#ifdef PROBE_REP
    fsync.sync(); p0_prologue(a, lds); fsync.sync();
    layer_fwd<0>(a, fsync, lds, 0, tprev, tsum); layer_fwd<1>(a, fsync, lds, 1, tprev, tsum); layer_fwd<0>(a, fsync, lds, 2, tprev, tsum); layer_fwd<1>(a, fsync, lds, 3, tprev, tsum);
    { OPAQUE_IDS(); const float* st = stat + (size_t)8 * STAT_ELEMS; const f32x4* gn = (const f32x4*)a.in[12] + lane; const int gw = vcu * 8 + wave, NGW = G * 8;
      const bf16_t* XBf = (const bf16_t*)(ws + WS_XB); const bf16_t* XLf = (const bf16_t*)(ws + WS_XL);
      f32x4 gv[4];
#pragma unroll
      for (int jj = 0; jj < 4; ++jj) gv[jj] = gn[64 * jj];
      for (int m = gw; m < M; m += NGW) { f32x4* xr = (f32x4*)(a.out + (size_t)m * D) + lane; const u32x2* h8 = (const u32x2*)(XBf + (size_t)m * D) + lane; const u32x2* l8 = (const u32x2*)(XLf + (size_t)m * D) + lane;
          const float rs = __builtin_amdgcn_rsqf(wave_sum(lane < 16 ? st[(size_t)m * 16 + lane] : 0.f) * (1.f / D) + EPS);
#pragma unroll
          for (int jj = 0; jj < 4; ++jj) { const u32x2 hw = FINLD(&h8[64 * jj]), lw = RES_LO ? FINLD(&l8[64 * jj]) : (u32x2){0u, 0u}; f32x4 v;
              v.x = __uint_as_float(hw.x << 16) + __uint_as_float(lw.x << 16); v.y = __uint_as_float(hw.x & 0xffff0000u) + __uint_as_float(lw.x & 0xffff0000u);
              v.z = __uint_as_float(hw.y << 16) + __uint_as_float(lw.y << 16); v.w = __uint_as_float(hw.y & 0xffff0000u) + __uint_as_float(lw.y & 0xffff0000u);
              v = v * rs * gv[jj];
#if defined(TSEL) && !defined(TFINAL)
              if (jj == 0 && lane < 4) v = v + tdelta;
#endif
#if 1
              __builtin_nontemporal_store(v, &xr[64 * jj]);
#else
              xr[64 * jj] = v;
#endif
          } } }
#endif
#ifdef TFINAL
    { unsigned long long* tw = (unsigned long long*)(ws + WS_END) + 8;
      grid.sync();
      const unsigned long long tn = __builtin_amdgcn_s_memrealtime();
      if (blockIdx.x == 0 && threadIdx.x == 0) { *tw = tn - tprev; __threadfence(); }
      grid.sync();
      const float td = (float)(*(volatile unsigned long long*)tw) * 1e-7f;
      OPAQUE_IDS(); const int gw = vcu * 8 + wave, NGW = G * 8;
      for (int m = gw; m < M; m += NGW) { if (lane < 4) { f32x4* xr = (f32x4*)(a.out + (size_t)m * D) + lane; xr[0] = xr[0] + td; } } }
#endif
}

extern "C" void kernel_launch(void* const* d_in, const int* in_sizes, int n_in, void* d_out, int out_size, void* d_ws, size_t ws_size, hipStream_t stream) {
    static int grid = 0;
    if (grid == 0) {
        if (n_in != 13 || in_sizes[0] != M * D || out_size != M * D || ws_size < WS_END) { fprintf(stderr, "kernel_launch: unexpected shapes (n_in %d, in0 %d, out %d, ws %zu)\n", n_in, n_in > 0 ? in_sizes[0] : -1, out_size, ws_size); grid = -1; return; }
        int dev = 0, cus = 0, per_cu = 0;
        if (hipGetDevice(&dev) != hipSuccess || hipDeviceGetAttribute(&cus, hipDeviceAttributeMultiprocessorCount, dev) != hipSuccess) { grid = -1; return; }
        if (hipFuncSetAttribute((const void*)fwd_megakernel, hipFuncAttributeMaxDynamicSharedMemorySize, LDS_BYTES) != hipSuccess) { fprintf(stderr, "kernel_launch: hipFuncSetAttribute failed\n"); grid = -1; return; }
        if (hipOccupancyMaxActiveBlocksPerMultiprocessor(&per_cu, (const void*)fwd_megakernel, 512, LDS_BYTES) != hipSuccess || per_cu < 1) { fprintf(stderr, "kernel_launch: occupancy query says %d\n", per_cu); per_cu = 1; }
        (void)hipGetLastError();
        grid = cus;
    }
    if (grid < 0) return;
    Args a{};
    for (int i = 0; i < 13; ++i) a.in[i] = (const float*)d_in[i];
    a.out = (float*)d_out; a.ws = (unsigned char*)d_ws;
    void* args[] = {&a};
    hipError_t e = hipLaunchCooperativeKernel((const void*)fwd_megakernel, dim3(grid), dim3(512), args, LDS_BYTES, stream);
    if (e != hipSuccess) fprintf(stderr, "kernel_launch: cooperative launch failed: %s (grid %d)\n", hipGetErrorString(e), grid);
}
```
